# Optimizing an MI355X kernel written in HIP

```python
import numpy as np
import jax, jax.numpy as jnp
from jax import lax


D_MODEL = 2048
BATCH = 2
SEQ = 16384
DEPTH = 1

MIX_WIDTH = D_MODEL
CONV_WIDTH = MIX_WIDTH // 2
CONV_GROUP = 128
CONV_KSIZE = 3
HEAD_DIM = 128
N_HEADS = (MIX_WIDTH - CONV_WIDTH) // HEAD_DIM
N_KV = 2
GROUP_R = N_HEADS // N_KV
ATTN_WIDTH = N_HEADS * HEAD_DIM
KV_WIDTH = N_KV * HEAD_DIM
CMP_BLOCK = 32
CMP_STRIDE = 16
CMP_HIDDEN = 2 * HEAD_DIM
SEL_BLOCK = 64
SEL_TOP_N = 16
WINDOW = 512
Q_BLOCK = 128
ROPE_THETA = 10000.0
D_FF = -(-8 * D_MODEL // (3 * 256)) * 256
IN_WIDTH = 3 * CONV_WIDTH + ATTN_WIDTH + 6 * KV_WIDTH + 3 * N_HEADS
EPS = 1e-6
NEG_INF = -1e30
FORCE_BONUS = 1e4

kernel_name = 'hymba_conv_nsa_adaln_block'


def rms_norm(x, g):
    xf = x.astype(jnp.float32)
    y = xf * lax.rsqrt(jnp.mean(xf * xf, axis=-1, keepdims=True) + EPS)
    return (y * g.astype(jnp.float32)).astype(x.dtype)


def modulate(h, shift, scale):
    return h * (1.0 + scale[:, None, :]) + shift[:, None, :]


def rope_tables(pos):
    inv = 1.0 / (ROPE_THETA ** (jnp.arange(0, HEAD_DIM, 2, dtype=jnp.float32) / HEAD_DIM))
    ang = pos.astype(jnp.float32)[..., None] * inv
    return jnp.cos(ang), jnp.sin(ang)


def apply_rope(x, cos, sin):
    cos = cos[:, :, None, :].astype(x.dtype)
    sin = sin[:, :, None, :].astype(x.dtype)
    x1, x2 = jnp.split(x, 2, axis=-1)
    return jnp.concatenate([x1 * cos - x2 * sin, x2 * cos + x1 * sin], axis=-1)


def masked_softmax(s, mask):
    return jax.nn.softmax(jnp.where(mask, s.astype(jnp.float32), NEG_INF), axis=-1)


def short_conv_mixer(b_gate, c_gate, h, conv_w):
    u = c_gate * h
    y = lax.conv_general_dilated(u, conv_w.astype(u.dtype)[:, None, :], window_strides=(1,),
                                 padding=[(CONV_KSIZE - 1, 0)],
                                 dimension_numbers=('NWC', 'WIO', 'NWC'),
                                 feature_group_count=CONV_WIDTH)
    return b_gate * y


def compress(kv, pe, w1, b1, w2):
    S = kv.shape[1]
    n_cmp = (S - CMP_BLOCK) // CMP_STRIDE + 1
    idx = np.arange(n_cmp)[:, None] * CMP_STRIDE + np.arange(CMP_BLOCK)[None, :]
    blocks = kv[:, idx] + pe[None, None, :, None, :]
    hid = jax.nn.gelu(jnp.einsum('bnlgd,ldh->bngh', blocks, w1) + b1)
    return jnp.einsum('bngh,he->bnge', hid, w2)


def nsa_mixer(q, k_cmp_raw, v_cmp_raw, k_slc, v_slc, k_win, v_win, gate_logits, positions,
              q_norm, k_norm, pe_k, k_w1, k_b1, k_w2, pe_v, v_w1, v_b1, v_w2):
    B, S = q.shape[0], q.shape[1]
    cos, sin = rope_tables(positions)
    q = apply_rope(rms_norm(q, q_norm), cos, sin)
    k_slc = apply_rope(rms_norm(k_slc, k_norm[1]), cos, sin)
    k_win = apply_rope(rms_norm(k_win, k_norm[2]), cos, sin)

    k_cmp = compress(k_cmp_raw, pe_k, k_w1, k_b1, k_w2)
    v_cmp = compress(v_cmp_raw, pe_v, v_w1, v_b1, v_w2)
    n_cmp = k_cmp.shape[1]
    cmp_start = np.arange(n_cmp) * CMP_STRIDE
    cmp_end = cmp_start + CMP_BLOCK - 1
    k_cmp = apply_rope(rms_norm(k_cmp, k_norm[0]), cos[:, cmp_end], sin[:, cmp_end])

    n_sel = S // SEL_BLOCK
    n_top = min(SEL_TOP_N, n_sel)
    sel_start = np.arange(n_sel) * SEL_BLOCK
    overlap = jnp.asarray(((cmp_start[:, None] < sel_start[None, :] + SEL_BLOCK)
                           & (cmp_end[:, None] >= sel_start[None, :])).astype(np.float32))
    cmp_end_j = jnp.asarray(cmp_end)

    ks_blocks = k_slc.reshape(B, n_sel, SEL_BLOCK, N_KV, HEAD_DIM).transpose(0, 3, 1, 2, 4)
    vs_blocks = v_slc.reshape(B, n_sel, SEL_BLOCK, N_KV, HEAD_DIM).transpose(0, 3, 1, 2, 4)
    pad = ((0, 0), (WINDOW, 0), (0, 0), (0, 0))
    kw_pad = jnp.pad(k_win, pad)
    vw_pad = jnp.pad(v_win, pad)
    qg = q.reshape(B, S, N_KV, GROUP_R, HEAD_DIM)
    gates = jax.nn.sigmoid(gate_logits.astype(jnp.float32)).astype(q.dtype)
    scale = HEAD_DIM ** -0.5
    gather_blocks = jax.vmap(jax.vmap(lambda blk, ix: blk[ix]))

    def block_fn(qi):
        q0 = qi * Q_BLOCK
        t = q0 + jnp.arange(Q_BLOCK)
        qb = lax.dynamic_slice_in_dim(qg, q0, Q_BLOCK, axis=1) * scale

        m_c = cmp_end_j[None, :] <= t[:, None]
        p_c = masked_softmax(jnp.einsum('bqgrd,bngd->bgrqn', qb, k_cmp), m_c)
        p_c = jnp.where(m_c, p_c, 0.0)
        o_cmp = jnp.einsum('bgrqn,bngd->bqgrd', p_c.astype(v_cmp.dtype), v_cmp)

        imp = jnp.einsum('bgrqn,nj->bgqj', p_c, overlap)
        j = jnp.arange(n_sel)[None, :]
        cur = (t // SEL_BLOCK)[:, None]
        valid = j * SEL_BLOCK <= t[:, None]
        forced = (j == 0) | (j == cur) | (j == cur - 1)
        score = jnp.where(valid, imp + FORCE_BONUS * forced, NEG_INF)
        _, idx = lax.top_k(score, n_top)
        ks = gather_blocks(ks_blocks, idx)
        vs = gather_blocks(vs_blocks, idx)
        tok = idx[..., None] * SEL_BLOCK + jnp.arange(SEL_BLOCK)
        m_s = (tok <= t[None, None, :, None, None]).reshape(B, N_KV, 1, Q_BLOCK, n_top * SEL_BLOCK)
        s_s = jnp.einsum('bqgrd,bgqnld->bgrqnl', qb, ks).reshape(B, N_KV, GROUP_R, Q_BLOCK, n_top * SEL_BLOCK)
        p_s = masked_softmax(s_s, m_s)
        o_slc = jnp.einsum('bgrqk,bgqkd->bqgrd', p_s.astype(vs.dtype),
                           vs.reshape(B, N_KV, Q_BLOCK, n_top * SEL_BLOCK, HEAD_DIM))

        kw = lax.dynamic_slice_in_dim(kw_pad, q0, WINDOW + Q_BLOCK, axis=1)
        vw = lax.dynamic_slice_in_dim(vw_pad, q0, WINDOW + Q_BLOCK, axis=1)
        kp = q0 - WINDOW + jnp.arange(WINDOW + Q_BLOCK)
        m_w = (kp[None, :] <= t[:, None]) & (kp[None, :] > t[:, None] - WINDOW) & (kp[None, :] >= 0)
        p_w = masked_softmax(jnp.einsum('bqgrd,bkgd->bgrqk', qb, kw), m_w)
        o_win = jnp.einsum('bgrqk,bkgd->bqgrd', p_w.astype(vw.dtype), vw)

        g = lax.dynamic_slice_in_dim(gates, q0, Q_BLOCK, axis=1).reshape(B, Q_BLOCK, N_KV, GROUP_R, 3)
        o = g[..., 0:1] * o_cmp + g[..., 1:2] * o_slc + g[..., 2:3] * o_win
        return o.reshape(B, Q_BLOCK, ATTN_WIDTH)

    out = lax.map(block_fn, jnp.arange(S // Q_BLOCK))
    return out.transpose(1, 0, 2, 3).reshape(B, S, ATTN_WIDTH)


def setup_inputs(seed: int = 0) -> dict:
    key = jax.random.key(seed)
    ks = jax.random.split(key, 24)
    f32 = jnp.float32
    L = DEPTH

    def nrm(k, shape, s):
        return jax.random.normal(k, shape, f32) * s

    def gain(k, shape):
        return 1.0 + 0.02 * jax.random.normal(k, shape, f32)

    return {
        'x': nrm(ks[0], (BATCH, SEQ, D_MODEL), 1.0),
        'c': nrm(ks[1], (BATCH, D_MODEL), 1.0),
        'positions': jnp.broadcast_to(jnp.arange(SEQ, dtype=jnp.int32), (BATCH, SEQ)),
        'ada_w': nrm(ks[2], (L, D_MODEL, 6 * D_MODEL), 0.5 * D_MODEL ** -0.5),
        'ada_b': nrm(ks[3], (L, 6 * D_MODEL), 0.01),
        'norm_mix': gain(ks[4], (L, D_MODEL)),
        'norm_ffn': gain(ks[5], (L, D_MODEL)),
        'w_in': nrm(ks[6], (L, D_MODEL, IN_WIDTH), D_MODEL ** -0.5),
        'conv_w': nrm(ks[7], (L, CONV_KSIZE, CONV_WIDTH), CONV_KSIZE ** -0.5),
        'cmp_pe_k': nrm(ks[8], (L, CMP_BLOCK, HEAD_DIM), 0.1),
        'cmp_k_w1': nrm(ks[9], (L, CMP_BLOCK, HEAD_DIM, CMP_HIDDEN), (CMP_BLOCK * HEAD_DIM) ** -0.5),
        'cmp_k_b1': nrm(ks[10], (L, CMP_HIDDEN), 0.01),
        'cmp_k_w2': nrm(ks[11], (L, CMP_HIDDEN, HEAD_DIM), CMP_HIDDEN ** -0.5),
        'cmp_pe_v': nrm(ks[12], (L, CMP_BLOCK, HEAD_DIM), 0.1),
        'cmp_v_w1': nrm(ks[13], (L, CMP_BLOCK, HEAD_DIM, CMP_HIDDEN), (CMP_BLOCK * HEAD_DIM) ** -0.5),
        'cmp_v_b1': nrm(ks[14], (L, CMP_HIDDEN), 0.01),
        'cmp_v_w2': nrm(ks[15], (L, CMP_HIDDEN, HEAD_DIM), CMP_HIDDEN ** -0.5),
        'q_norm': gain(ks[16], (L, HEAD_DIM)),
        'k_norm': gain(ks[17], (L, 3, HEAD_DIM)),
        'out_norm_conv': gain(ks[18], (L, CONV_WIDTH)),
        'out_norm_attn': gain(ks[19], (L, ATTN_WIDTH)),
        'w_out': nrm(ks[20], (L, MIX_WIDTH, D_MODEL), MIX_WIDTH ** -0.5),
        'ffn_w1': nrm(ks[21], (L, D_MODEL, D_FF), D_MODEL ** -0.5),
        'ffn_w3': nrm(ks[22], (L, D_MODEL, D_FF), D_MODEL ** -0.5),
        'ffn_w2': nrm(ks[23], (L, D_FF, D_MODEL), D_FF ** -0.5),
    }


def reference(x, c, positions, ada_w, ada_b, norm_mix, norm_ffn, w_in, conv_w,
              cmp_pe_k, cmp_k_w1, cmp_k_b1, cmp_k_w2, cmp_pe_v, cmp_v_w1, cmp_v_b1, cmp_v_w2,
              q_norm, k_norm, out_norm_conv, out_norm_attn, w_out, ffn_w1, ffn_w3, ffn_w2):
    B, S = x.shape[0], x.shape[1]
    splits = [int(v) for v in np.cumsum([CONV_WIDTH] * 3 + [ATTN_WIDTH] + [KV_WIDTH] * 6)]
    for l in range(DEPTH):
        sh_a, sc_a, g_a, sh_f, sc_f, g_f = jnp.split(jax.nn.silu(c) @ ada_w[l] + ada_b[l], 6, axis=-1)

        h = modulate(rms_norm(x, norm_mix[l]), sh_a, sc_a)
        proj = h @ w_in[l]
        cb, cc, ch, q, kc, vc, ksl, vsl, kw, vw, gl = jnp.split(proj, splits, axis=-1)

        y_conv = short_conv_mixer(cb, cc, ch, conv_w[l])
        y_conv = rms_norm(y_conv.reshape(B, S, CONV_WIDTH // CONV_GROUP, CONV_GROUP),
                          out_norm_conv[l].reshape(CONV_WIDTH // CONV_GROUP, CONV_GROUP)).reshape(B, S, CONV_WIDTH)

        y_attn = nsa_mixer(q.reshape(B, S, N_HEADS, HEAD_DIM),
                           kc.reshape(B, S, N_KV, HEAD_DIM), vc.reshape(B, S, N_KV, HEAD_DIM),
                           ksl.reshape(B, S, N_KV, HEAD_DIM), vsl.reshape(B, S, N_KV, HEAD_DIM),
                           kw.reshape(B, S, N_KV, HEAD_DIM), vw.reshape(B, S, N_KV, HEAD_DIM),
                           gl.reshape(B, S, N_HEADS, 3), positions, q_norm[l], k_norm[l],
                           cmp_pe_k[l], cmp_k_w1[l], cmp_k_b1[l], cmp_k_w2[l],
                           cmp_pe_v[l], cmp_v_w1[l], cmp_v_b1[l], cmp_v_w2[l])
        y_attn = rms_norm(y_attn.reshape(B, S, N_HEADS, HEAD_DIM),
                          out_norm_attn[l].reshape(N_HEADS, HEAD_DIM)).reshape(B, S, ATTN_WIDTH)

        x = x + g_a[:, None, :] * (jnp.concatenate([y_conv, y_attn], axis=-1) @ w_out[l])

        h = modulate(rms_norm(x, norm_ffn[l]), sh_f, sc_f)
        x = x + g_f[:, None, :] * ((jax.nn.silu(h @ ffn_w1[l]) * (h @ ffn_w3[l])) @ ffn_w2[l])
    return x
```

```cpp
#include <hip/hip_runtime.h>
#include <hip/hip_cooperative_groups.h>
#include <cstdio>
#include <cstdint>
namespace cg = cooperative_groups;

#define DI __device__ __forceinline__
#define LAS __attribute__((address_space(3)))
typedef unsigned short bf16_t;
typedef short bf16x8 __attribute__((ext_vector_type(8)));
typedef float f32x2 __attribute__((ext_vector_type(2)));
typedef float f32x4 __attribute__((ext_vector_type(4)));
typedef float f32x16 __attribute__((ext_vector_type(16)));
typedef unsigned u32x2 __attribute__((ext_vector_type(2)));
typedef unsigned u32x4 __attribute__((ext_vector_type(4)));
typedef __bf16 bf16v2 __attribute__((ext_vector_type(2)));

constexpr int NB = 2, S = 16384, T = NB * S, D = 2048, CONVW = 1024, INW = 5656, INWP = 5888, DFF = 5632;
constexpr float EPS = 1e-6f;
constexpr size_t MiB = 1u << 20;
constexpr size_t WS_ADA = 0, WS_ROPE = 1 * MiB, WS_WIN = 17 * MiB, WS_WOUT = 40 * MiB, WS_W13 = 48 * MiB, WS_W2 = 92 * MiB,
                 WS_CW1K = 114 * MiB, WS_CW1V = 116 * MiB, WS_CB1 = 118 * MiB, WS_HID = 119 * MiB, WS_KCMP = 127 * MiB, WS_VCMPT = 128 * MiB,
                 WS_GL = 129 * MiB, WS_KV6 = 132 * MiB, WS_KSL = 230 * MiB, WS_KWN = 246 * MiB, WS_VSLT = 262 * MiB, WS_VWNT = 278 * MiB,
                 WS_QR = 294 * MiB, WS_CONVIN = 358 * MiB, WS_XN = 614 * MiB, WS_Y = 742 * MiB, WS_ACT = 230 * MiB, WS_QR8 = 870 * MiB, WS_KSL32 = 902 * MiB, WS_VSL32 = 918 * MiB, WS_X1B = 870 * MiB  , WS_END = 998 * MiB;
constexpr size_t WS_SUMSQ = WS_CB1 + 65536, WS_BIAS13 = WS_CB1 + 262144;
constexpr size_t WS_BAR = WS_CB1 + 524288;
constexpr int LDS_BYTES = 8 * 17536 + 64;
constexpr int WAVE_LDS = 17536;

DI unsigned pk2(float lo, float hi) { f32x2 v = {lo, hi}; bf16v2 b = __builtin_convertvector(v, bf16v2); return __builtin_bit_cast(unsigned, b); }
DI float bf2f(bf16_t v) { return __uint_as_float((unsigned)v << 16); }
DI float wsum64(float v) {
#pragma unroll
    for (int o = 1; o < 64; o <<= 1) v += __shfl_xor(v, o);
    return v;
}
DI float sigmoidf_(float x) { return __builtin_amdgcn_rcpf(1.f + __expf(-x)); }
#define LDS_WAIT() asm volatile("s_waitcnt lgkmcnt(0)" ::: "memory")
DI int opaque(int x) { asm volatile("" : "+v"(x)); return x; }

namespace pg8 {
constexpr int BM = 256, BK = 64, HALF = 128, HTB = HALF * BK * 2, STAGE_BYTES = 8 * HTB, NXCD = 8;
__host__ __device__ __forceinline__ int lds_byte(int r, int c) { const int st = (r >> 4) * 2 + (c >> 5), rr = r & 15, cc = c & 31, ob = rr * 64 + cc * 2; return st * 1024 + (ob ^ (((ob >> 9) & 1) << 5)); }
__host__ __device__ __forceinline__ void stage_rc(int b, int& R, int& C) { const int st = b / 1024, sb = b % 1024, swz = sb ^ (((sb >> 9) & 1) << 5); R = (st >> 1) * 16 + swz / 64; C = (st & 1) * 32 + (swz % 64) / 2; }
__host__ __device__ __forceinline__ int perm32(int rho) { const int n = rho >> 4, i = rho & 15; return 8 * (i >> 2) + 4 * n + (i & 3); }
struct Unit { int pm, pn; };
struct Gemm { const bf16_t* A; const bf16_t* Bt; int M, N, K, lda; };
struct StaticOrder {
    int nM, nN, nwg, G, c, WGM;
    __device__ void init(int M, int N, int G_, int c_, int wgm) { nM = M / BM; nN = N / BM; nwg = nM * nN; G = G_; c = c_; WGM = wgm; }
    __device__ bool next(int i, Unit& u) const {
        const long L = (long)i * G + c; if (L >= nwg) return false;
        int wgid = (int)L; { const int q = nwg / NXCD, r = nwg % NXCD, xcd = wgid % NXCD, off = wgid / NXCD; wgid = (xcd < r ? xcd * (q + 1) : r * (q + 1) + (xcd - r) * q) + off; }
        const int nig = WGM * nN, gid = wgid / nig, fm = gid * WGM, gsz = (nM - fm) < WGM ? (nM - fm) : WGM;
        u.pm = fm + ((wgid % nig) % gsz); u.pn = (wgid % nig) / gsz; return true;
    }
};
struct OneUnit { int pm; __device__ bool next(int i, Unit& u) const { if (i) return false; u.pm = pm; u.pn = 0; return true; } };

template <class Epi, class Sched, bool ALIGN_EPI>
DI void gemm_phase(LAS unsigned char* lds, const Gemm g, const Sched& S_, const Epi& E) {
    const int tid = opaque((int)threadIdx.x), wid = __builtin_amdgcn_readfirstlane(tid >> 6), lane = tid & 63, wr = wid >> 2, wc = wid & 3, fr = lane & 15, fq = lane >> 4;
    const int K = g.K, nt = K / BK, lda = g.lda;
    unsigned voffA[2], voffB[2];
#pragma unroll
    for (int i = 0; i < 2; ++i) { int R, C; stage_rc(tid * 16 + i * 8192, R, C); const int Rb = Epi::PERM ? ((R & ~31) + perm32(R & 31)) : R;
        voffA[i] = (unsigned)(R * lda + C) * 2u; voffB[i] = (unsigned)(Rb * K + C) * 2u; }
    const size_t kstep = (size_t)(BK * 2);
    const size_t hstepA = (size_t)HALF * lda * 2, hstepB = (size_t)HALF * K * 2;
    const size_t tstepA = 2 * hstepA, tstepB = 2 * hstepB;
    const unsigned ldsw = (unsigned)wid * 1024u;
    const int aoff = lds_byte(wr * 64 + fr, fq * 8), boff = lds_byte(wc * 32 + fr, fq * 8);
#define PG8_SA(b, h) (((b) * 2 + (h)) * HTB)
#define PG8_SB(b, h) ((4 + (b) * 2 + (h)) * HTB)
#define PG8_STAGE(bufoff, gbase, voff) do { _Pragma("unroll") for (int _i = 0; _i < 2; ++_i) \
        __builtin_amdgcn_global_load_lds((const unsigned*)((const char*)(gbase) + (voff)[_i]), (LAS unsigned*)(lds + (bufoff) + ldsw + _i * 8192), 16, 0, 0); } while (0)
#define PG8_LDA(dst, b, h) do { _Pragma("unroll") for (int m = 0; m < 4; ++m) _Pragma("unroll") for (int k = 0; k < 2; ++k) dst[m][k] = *(const LAS bf16x8*)(lds + PG8_SA(b, h) + aoff + m * 2048 + k * 1024); } while (0)
#define PG8_LDB(dst, b, h) do { _Pragma("unroll") for (int n = 0; n < 2; ++n) _Pragma("unroll") for (int k = 0; k < 2; ++k) dst[n][k] = *(const LAS bf16x8*)(lds + PG8_SB(b, h) + boff + n * 2048 + k * 1024); } while (0)
#define PG8_MMA(ai, bj, At, Bt) do { __builtin_amdgcn_s_setprio(1); _Pragma("unroll") for (int m = 0; m < 4; ++m) _Pragma("unroll") for (int n = 0; n < 2; ++n) _Pragma("unroll") for (int k = 0; k < 2; ++k) \
        acc[ai][bj][m][n] = __builtin_amdgcn_mfma_f32_16x16x32_bf16(Bt[n][k], At[m][k], acc[ai][bj][m][n], 0, 0, 0); __builtin_amdgcn_s_setprio(0); } while (0)
#define PG8_WAIT_V(n) asm volatile("s_waitcnt vmcnt(" #n ")" ::: "memory")
#define PG8_WAIT_L(n) asm volatile("s_waitcnt lgkmcnt(" #n ")" ::: "memory")
#define PG8_BAR __builtin_amdgcn_s_barrier()
#define PG8_SCHED __builtin_amdgcn_sched_barrier(0)
    Unit cur, nxt; int ui = 0;
    if (!S_.next(0, cur)) return;
    f32x4 acc[2][2][4][2];
#pragma unroll
    for (int a = 0; a < 2; ++a)
#pragma unroll
        for (int b = 0; b < 2; ++b)
#pragma unroll
            for (int m = 0; m < 4; ++m)
#pragma unroll
                for (int n = 0; n < 2; ++n) acc[a][b][m][n] = (f32x4){0.f, 0.f, 0.f, 0.f};
    bf16x8 At[4][2], B0[2][2], B1[2][2];
    const char* cA = (const char*)g.A + (size_t)cur.pm * tstepA; const char* cB = (const char*)g.Bt + (size_t)cur.pn * tstepB;
    PG8_STAGE(PG8_SB(0, 0), cB, voffB); PG8_STAGE(PG8_SB(0, 1), cB + hstepB, voffB); PG8_STAGE(PG8_SA(0, 0), cA, voffA); PG8_STAGE(PG8_SA(0, 1), cA + hstepA, voffA);
    if (wr == 1) PG8_BAR;
    PG8_WAIT_V(2); PG8_BAR;
    PG8_STAGE(PG8_SB(1, 0), cB + kstep, voffB); PG8_STAGE(PG8_SA(1, 0), cA + kstep, voffA); PG8_STAGE(PG8_SB(1, 1), cB + hstepB + kstep, voffB);
    PG8_WAIT_V(6); PG8_BAR;
    for (;;) {
        const bool has_next = S_.next(ui + 1, nxt);
        const char* nA = has_next ? (const char*)g.A + (size_t)nxt.pm * tstepA : cA; const char* nB = has_next ? (const char*)g.Bt + (size_t)nxt.pn * tstepB : cB;
        for (int t = 0; t < nt; t += 2) {
            const bool last = (t == nt - 2);
            const char* a1 = cA + (size_t)(t + 1) * kstep;
            const char* a2 = last ? nA : cA + (size_t)(t + 2) * kstep; const char* b2 = last ? nB : cB + (size_t)(t + 2) * kstep;
            const char* a3 = a2 + kstep; const char* b3 = b2 + kstep;
            PG8_LDB(B0, 0, 0); PG8_LDB(B1, 0, 1); PG8_SCHED; PG8_LDA(At, 0, 0); PG8_STAGE(PG8_SA(1, 1), a1 + hstepA, voffA);
            PG8_WAIT_V(8); PG8_WAIT_L(0); PG8_BAR; PG8_MMA(0, 0, At, B0); PG8_MMA(0, 1, At, B1); PG8_BAR; PG8_SCHED;
            PG8_LDA(At, 0, 1); PG8_STAGE(PG8_SB(0, 0), b2, voffB); PG8_STAGE(PG8_SB(0, 1), b2 + hstepB, voffB); PG8_STAGE(PG8_SA(0, 0), a2, voffA);
            PG8_WAIT_V(8); PG8_WAIT_L(0); PG8_BAR; PG8_MMA(1, 0, At, B0); PG8_MMA(1, 1, At, B1); PG8_BAR; PG8_SCHED;
            PG8_LDB(B0, 1, 0); PG8_LDB(B1, 1, 1); PG8_SCHED; PG8_LDA(At, 1, 0); PG8_STAGE(PG8_SA(0, 1), a2 + hstepA, voffA);
            PG8_WAIT_V(8); PG8_WAIT_L(0); PG8_BAR; PG8_MMA(0, 0, At, B0); PG8_MMA(0, 1, At, B1); PG8_BAR; PG8_SCHED;
            PG8_LDA(At, 1, 1); PG8_STAGE(PG8_SB(1, 0), b3, voffB); PG8_STAGE(PG8_SB(1, 1), b3 + hstepB, voffB); PG8_STAGE(PG8_SA(1, 0), a3, voffA);
            PG8_WAIT_V(8); PG8_WAIT_L(0); PG8_BAR; PG8_MMA(1, 0, At, B0); PG8_MMA(1, 1, At, B1); PG8_BAR; PG8_SCHED;
        }
        if constexpr (ALIGN_EPI) { if (wr == 0) PG8_BAR; }
        E(acc, cur, wr, wc, fr, fq);
        if (!has_next) break;
#pragma unroll
        for (int a = 0; a < 2; ++a)
#pragma unroll
            for (int b = 0; b < 2; ++b)
#pragma unroll
                for (int m = 0; m < 4; ++m)
#pragma unroll
                    for (int n = 0; n < 2; ++n) acc[a][b][m][n] = (f32x4){0.f, 0.f, 0.f, 0.f};
        cur = nxt; cA = nA; cB = nB; ++ui;
        if constexpr (ALIGN_EPI) { if (wr == 1) PG8_BAR; }
    }
    PG8_WAIT_V(0);
    if constexpr (!ALIGN_EPI) { if (wr == 0) PG8_BAR; }
    PG8_BAR;
#undef PG8_SA
#undef PG8_SB
#undef PG8_STAGE
#undef PG8_LDA
#undef PG8_LDB
#undef PG8_MMA
#undef PG8_WAIT_V
#undef PG8_WAIT_L
#undef PG8_BAR
#undef PG8_SCHED
}

struct EpiProj {
    static constexpr bool PERM = true;
    bf16_t* convin; bf16_t* kv6; float* gl;
    DI void operator()(const f32x4 (&acc)[2][2][4][2], const Unit& u, int wr, int wc, int fr, int fq) const {
        const int row0 = u.pm * BM + wr * 64 + fr;
#pragma unroll
        for (int ai = 0; ai < 2; ++ai)
#pragma unroll
            for (int m = 0; m < 4; ++m) {
                const int row = row0 + ai * HALF + m * 16;
#pragma unroll
                for (int bj = 0; bj < 2; ++bj) {
                    const f32x4 v0 = acc[ai][bj][m][0], v1 = acc[ai][bj][m][1];
                    u32x4 w; w.x = pk2(v0[0], v0[1]); w.y = pk2(v0[2], v0[3]); w.z = pk2(v1[0], v1[1]); w.w = pk2(v1[2], v1[3]);
                    if (u.pn < 16) {
                        *(u32x4*)(convin + (size_t)row * 4096 + u.pn * 256 + bj * HALF + wc * 32 + 8 * fq) = w;
                    } else if (u.pn < 22) {
                        const int ti = u.pn - 16, b = row >> 14, s = row & (S - 1);
                        *(u32x4*)(kv6 + ((size_t)((ti * 4 + b * 2 + bj)) * S + s) * 128 + wc * 32 + 8 * fq) = w;
                    } else if (bj == 0 && wc == 0 && fq < 3) {
                        *(f32x4*)(gl + (size_t)row * 24 + 8 * fq) = v0; *(f32x4*)(gl + (size_t)row * 24 + 8 * fq + 4) = v1;
                    }
                }
            }
    }
};
struct EpiHid {
    static constexpr bool PERM = true;
    float* hid; const float* bias;
    DI void operator()(const f32x4 (&acc)[2][2][4][2], const Unit& u, int wr, int wc, int fr, int fq) const {
        const int row0 = u.pm * BM + wr * 64 + fr;
#pragma unroll
        for (int bj = 0; bj < 2; ++bj) {
            const int col = bj * HALF + wc * 32 + 8 * fq;
            const f32x4 b0 = *(const f32x4*)(bias + col), b1 = *(const f32x4*)(bias + col + 4);
#pragma unroll
            for (int ai = 0; ai < 2; ++ai)
#pragma unroll
                for (int m = 0; m < 4; ++m) {
                    const int row = row0 + ai * HALF + m * 16;
                    f32x4 v0 = acc[ai][bj][m][0] + b0, v1 = acc[ai][bj][m][1] + b1;
#pragma unroll
                    for (int e = 0; e < 4; ++e) {
                        float x = v0[e]; float z = 0.7978845608f * (x + 0.044715f * x * x * x); v0[e] = x * __builtin_amdgcn_rcpf(1.f + __expf(-2.f * z));
                        x = v1[e]; z = 0.7978845608f * (x + 0.044715f * x * x * x); v1[e] = x * __builtin_amdgcn_rcpf(1.f + __expf(-2.f * z));
                    }
                    *(f32x4*)(hid + (size_t)row * 256 + col) = v0; *(f32x4*)(hid + (size_t)row * 256 + col + 4) = v1;
                }
        }
    }
};
struct EpiRes {
    static constexpr bool PERM = true;
    const bf16_t* base; float* out; const float* gate;
    DI void operator()(const f32x4 (&acc)[2][2][4][2], const Unit& u, int wr, int wc, int fr, int fq) const {
        const int row0 = u.pm * BM + wr * 64 + fr, col0 = u.pn * BM + wc * 32 + 8 * fq;
        const int b = (u.pm * BM) >> 14;
#pragma unroll
        for (int bj = 0; bj < 2; ++bj) {
            const int col = col0 + bj * HALF;
            const f32x4 g0 = *(const f32x4*)(gate + (size_t)b * 12288 + col), g1 = *(const f32x4*)(gate + (size_t)b * 12288 + col + 4);
#pragma unroll
            for (int ai = 0; ai < 2; ++ai)
#pragma unroll
                for (int m = 0; m < 4; ++m) {
                    const size_t off = (size_t)(row0 + ai * HALF + m * 16) * D + col;
                    const u32x4 bw = *(const u32x4*)(base + off);
                    const f32x4 b0 = {__uint_as_float(bw.x << 16), __uint_as_float(bw.x & 0xffff0000u), __uint_as_float(bw.y << 16), __uint_as_float(bw.y & 0xffff0000u)};
                    const f32x4 b1 = {__uint_as_float(bw.z << 16), __uint_as_float(bw.z & 0xffff0000u), __uint_as_float(bw.w << 16), __uint_as_float(bw.w & 0xffff0000u)};
                    __builtin_nontemporal_store(b0 + g0 * acc[ai][bj][m][0], (f32x4*)(out + off)); __builtin_nontemporal_store(b1 + g1 * acc[ai][bj][m][1], (f32x4*)(out + off + 4));
                }
        }
    }
};
struct EpiRes2 {
    static constexpr bool PERM = true;
    const float* base; bf16_t* out; const float* gate; const float* gain; const float* scl; bf16_t* xs; float* sumsq;
    DI void operator()(const f32x4 (&acc)[2][2][4][2], const Unit& u, int wr, int wc, int fr, int fq) const {
        const int row0 = u.pm * BM + wr * 64 + fr, col0 = u.pn * BM + wc * 32 + 8 * fq;
        const int b = (u.pm * BM) >> 14;
        float ss[2][4];
#pragma unroll
        for (int ai = 0; ai < 2; ++ai)
#pragma unroll
            for (int m = 0; m < 4; ++m) ss[ai][m] = 0.f;
#pragma unroll
        for (int bj = 0; bj < 2; ++bj) {
            const int col = col0 + bj * HALF;
            const f32x4 gv0 = *(const f32x4*)(gate + (size_t)b * 12288 + col), gv1 = *(const f32x4*)(gate + (size_t)b * 12288 + col + 4);
            const f32x4 gm0 = *(const f32x4*)(gain + col) * (*(const f32x4*)(scl + (size_t)b * 12288 + col) + 1.f), gm1 = *(const f32x4*)(gain + col + 4) * (*(const f32x4*)(scl + (size_t)b * 12288 + col + 4) + 1.f);
#pragma unroll
            for (int ai = 0; ai < 2; ++ai)
#pragma unroll
                for (int m = 0; m < 4; ++m) {
                    const size_t off = (size_t)(row0 + ai * HALF + m * 16) * D + col;
                    const f32x4 xa = __builtin_nontemporal_load((const f32x4*)(base + off)) + gv0 * acc[ai][bj][m][0], xb = __builtin_nontemporal_load((const f32x4*)(base + off + 4)) + gv1 * acc[ai][bj][m][1];
                    { u32x4 w1; w1.x = pk2(xa.x, xa.y); w1.y = pk2(xa.z, xa.w); w1.z = pk2(xb.x, xb.y); w1.w = pk2(xb.z, xb.w); *(u32x4*)(out + off) = w1; }
                    ss[ai][m] += ((xa.x * xa.x + xa.y * xa.y) + (xa.z * xa.z + xa.w * xa.w)) + ((xb.x * xb.x + xb.y * xb.y) + (xb.z * xb.z + xb.w * xb.w));
                    const f32x4 ma = xa * gm0, mb = xb * gm1; u32x4 w; w.x = pk2(ma.x, ma.y); w.y = pk2(ma.z, ma.w); w.z = pk2(mb.x, mb.y); w.w = pk2(mb.z, mb.w);
                    *(u32x4*)(xs + off) = w;
                }
        }
#pragma unroll
        for (int ai = 0; ai < 2; ++ai)
#pragma unroll
            for (int m = 0; m < 4; ++m) { float v = ss[ai][m]; v += __shfl_xor(v, 16); v += __shfl_xor(v, 32);
                if (fq == 0) atomicAdd(sumsq + row0 + ai * HALF + m * 16, v); }
    }
};
struct EpiSwiGLU {
    static constexpr bool PERM = true;
    bf16_t* act; const float* sumsq; const float* bias;
    DI void operator()(const f32x4 (&acc)[2][2][4][2], const Unit& u, int wr, int wc, int fr, int fq) const {
        const int row0 = u.pm * BM + wr * 64 + fr, col = u.pn * HALF + wc * 32 + 8 * fq;
        const int b = (u.pm * BM) >> 14;
        const float* bp = bias + (size_t)b * (2 * DFF) + u.pn * BM + wc * 32 + 8 * fq;
        const f32x4 ba0 = *(const f32x4*)bp, ba1 = *(const f32x4*)(bp + 4), bb0 = *(const f32x4*)(bp + HALF), bb1 = *(const f32x4*)(bp + HALF + 4);
#pragma unroll
        for (int ai = 0; ai < 2; ++ai)
#pragma unroll
            for (int m = 0; m < 4; ++m) {
                const int row = row0 + ai * HALF + m * 16;
                const float rstd = rsqrtf(sumsq[row] * (1.f / D) + EPS);
                float o[8];
#pragma unroll
                for (int n = 0; n < 2; ++n)
#pragma unroll
                    for (int e = 0; e < 4; ++e) { const float a = acc[ai][0][m][n][e] * rstd + (n ? ba1[e] : ba0[e]), bv = acc[ai][1][m][n][e] * rstd + (n ? bb1[e] : bb0[e]);
                        o[4 * n + e] = a * __builtin_amdgcn_rcpf(1.f + __expf(-a)) * bv; }
                u32x4 w; w.x = pk2(o[0], o[1]); w.y = pk2(o[2], o[3]); w.z = pk2(o[4], o[5]); w.w = pk2(o[6], o[7]);
                *(u32x4*)(act + (size_t)row * DFF + col) = w;
            }
    }
};
}

#define XB_TMO      128
#define XB_XCNT(j)  (256  + 64 * (j))
#define XB_XSUB(j)  (1280 + 64 * (j))
#define XB_XGEN(j)  (2304 + 64 * (j))
#define XB_TOP      3328
#define XB_TOPGEN   3392
#define XCD_BAR_WORDS 3456
#define XB_SPIN_CAP (1u << 18)

__device__ __forceinline__ unsigned xb_ld(unsigned* p)              { return __hip_atomic_load(p, __ATOMIC_RELAXED, __HIP_MEMORY_SCOPE_AGENT); }
__device__ __forceinline__ unsigned xb_add(unsigned* p, unsigned v) { return __hip_atomic_fetch_add(p, v, __ATOMIC_RELAXED, __HIP_MEMORY_SCOPE_AGENT); }
__device__ __forceinline__ unsigned xb_xcc_id() { return (unsigned)__builtin_amdgcn_s_getreg((3 << 11) | 20) & 0xFu; }
#define XB_SPIN(cond, bar) do { unsigned _sp = 0; while (cond) { __builtin_amdgcn_s_sleep(1); \
    if ((++_sp & 255u) == 0u) { if (xb_ld(&(bar)[XB_TMO])) break; if (_sp > XB_SPIN_CAP) { atomicAdd(&(bar)[XB_TMO], 1u); break; } } } } while (0)

struct XcdBarrier {
    unsigned* bar; unsigned x;
    volatile LAS unsigned* st;
};

__device__ __forceinline__ XcdBarrier xcd_barrier_post(unsigned* bar, volatile LAS unsigned* st) {
    XcdBarrier b; b.bar = bar; b.x = xb_xcc_id(); b.st = st;
    if (threadIdx.x == 0) (void)xb_add(&bar[XB_XCNT(b.x)], 1u);
    return b;
}
__device__ __forceinline__ void xcd_barrier_complete(unsigned* bar, unsigned x, unsigned& nloc, unsigned& nx) {
    const unsigned G = gridDim.x * gridDim.y * gridDim.z;
    unsigned sum, cnt, mine, sp = 0u;
    for (;;) {
        sum = 0u; cnt = 0u; mine = 0u;
#pragma unroll
        for (unsigned j = 0; j < 16; ++j) { const unsigned c = xb_ld(&bar[XB_XCNT(j)]); sum += c; cnt += (c > 0u) ? 1u : 0u; mine = (j == x) ? c : mine; }
        if (sum == G) break;
        __builtin_amdgcn_s_sleep(1);
        if ((++sp & 255u) == 0u) { if (xb_ld(&bar[XB_TMO])) break; if (sp > XB_SPIN_CAP) { atomicAdd(&bar[XB_TMO], 1u); break; } }
    }
    nloc = mine > 0u ? mine : 1u; nx = cnt > 0u ? cnt : 1u;
}

__device__ __forceinline__ void xcd_barrier(const XcdBarrier& b) {
    asm volatile("s_waitcnt vmcnt(0)" ::: "memory");
    __syncthreads();
    if (threadIdx.x == 0) {
        unsigned* bar = b.bar;
        __builtin_amdgcn_s_waitcnt(0);
        unsigned nloc = b.st[0], nx = b.st[1];
        if (nloc == 0u) { xcd_barrier_complete(bar, b.x, nloc, nx); b.st[0] = nloc; b.st[1] = nx; }
        const unsigned old = xb_add(&bar[XB_XSUB(b.x)], 1u);
        const unsigned gen = old / nloc;
        if (old + 1u == (gen + 1u) * nloc) {
            __builtin_amdgcn_fence(__ATOMIC_RELEASE, "agent");
            asm volatile("s_waitcnt vmcnt(0)" ::: "memory");
            const unsigned og = xb_add(&bar[XB_TOP], 1u);
            const unsigned tg = og / nx;
            if (og + 1u == (tg + 1u) * nx) xb_add(&bar[XB_TOPGEN], 1u);
            else XB_SPIN(xb_ld(&bar[XB_TOPGEN]) == tg, bar);
            __builtin_amdgcn_fence(__ATOMIC_ACQUIRE, "agent");
            xb_add(&bar[XB_XGEN(b.x)], 1u);
            asm volatile("s_waitcnt vmcnt(0)" ::: "memory");
        } else {
            XB_SPIN(xb_ld(&bar[XB_XGEN(b.x)]) == gen, bar);
            __builtin_amdgcn_fence(__ATOMIC_ACQUIRE, "agent");
            asm volatile("s_waitcnt vmcnt(0)" ::: "memory");
        }
    }
    __syncthreads();
}


struct Args { const float* in[25]; float* out; unsigned char* ws; };
enum { I_X = 0, I_C, I_POS, I_ADAW, I_ADAB, I_NMIX, I_NFFN, I_WIN, I_CONVW, I_PEK, I_KW1, I_KB1, I_KW2, I_PEV, I_VW1, I_VB1, I_VW2, I_QN, I_KN, I_ONC, I_ONA, I_WOUT, I_W1, I_W3, I_W2 };

DI void transpose_item(const float* W, int K, int N, bf16_t* WT, int mode, LAS float* scr, int item, int lane, const float* kscA = nullptr, const float* kscB = nullptr) {
    const int nblk = (N + 63) / 64, kb = item / nblk, nb = item % nblk, k0 = 64 * kb, n0 = 64 * nb;
    const int nn = n0 + lane; const bool okc = nn < N;
    const float* wp = W + (size_t)k0 * N + (okc ? nn : 0);
#pragma unroll 16
    for (int i = 0; i < 64; ++i) { const int kg = k0 + i; float v = wp[(size_t)i * N]; if (kscA) v *= (kg < 1024 ? kscA[kg] : kscB[kg - 1024]); scr[i * 65 + lane] = okc ? v : 0.f; }
    LDS_WAIT();
    const int c = lane & 7;
#pragma unroll
    for (int j = 0; j < 8; ++j) { const int n = (lane >> 3) + 8 * j; const LAS float* sp = scr + (8 * c) * 65 + n;
        u32x4 o; o.x = pk2(sp[0 * 65], sp[1 * 65]); o.y = pk2(sp[2 * 65], sp[3 * 65]); o.z = pk2(sp[4 * 65], sp[5 * 65]); o.w = pk2(sp[6 * 65], sp[7 * 65]);
        const int ng = n0 + n;
        if (ng < N) { const int row = mode == 0 ? ng : (256 * (ng >> 7) + (ng & 127) + (mode == 2 ? 128 : 0)); *(u32x4*)(WT + (size_t)row * K + k0 + 8 * c) = o; } }
    LDS_WAIT();
}

DI void p0_prologue(const Args& a, LAS unsigned char* lds, int tid, int lane, int wave, int G) {
    unsigned char* ws = a.ws;
    const int gw = blockIdx.x * 8 + wave, NGW = G * 8;
    float* ADA = (float*)(ws + WS_ADA); float* CB1 = (float*)(ws + WS_CB1);
    LAS float* red = (LAS float*)lds;
    for (int task = blockIdx.x; task < 100; task += G) {
        const float *W, *v0, *v1, *bias; float *o0, *o1; int K, N, col0; bool dosilu;
        if (task < 96) { W = a.in[I_ADAW]; K = 2048; N = 12288; col0 = task * 128; v0 = a.in[I_C]; v1 = a.in[I_C] + 2048; dosilu = true; bias = a.in[I_ADAB] + col0; o0 = ADA + col0; o1 = ADA + 12288 + col0; }
        else { const int kv = (task - 96) >> 1, cgp = (task - 96) & 1; W = a.in[kv ? I_VW1 : I_KW1]; K = 4096; N = 256; col0 = cgp * 128; v0 = a.in[kv ? I_PEV : I_PEK]; v1 = nullptr; dosilu = false;
            bias = a.in[kv ? I_VB1 : I_KB1] + col0; o0 = CB1 + kv * 256 + col0; o1 = nullptr; }
        LAS float* vec = (LAS float*)(lds + 8192);
        for (int i = tid; i < K; i += 512) { float c0 = v0[i]; if (dosilu) c0 = c0 * __builtin_amdgcn_rcpf(1.f + __expf(-c0)); vec[i] = c0;
            float c1 = 0.f; if (v1) { c1 = v1[i]; c1 = c1 * __builtin_amdgcn_rcpf(1.f + __expf(-c1)); } vec[4096 + i] = c1; }
        __syncthreads();
        const int kper = K / 8; f32x2 a0 = {0.f, 0.f}, a1 = {0.f, 0.f};
        const float* wp = W + (size_t)(wave * kper) * N + col0 + 2 * lane;
        const LAS float* vp = vec + wave * kper;
#pragma unroll 16
        for (int k = 0; k < kper; ++k) { const f32x2 w = *(const f32x2*)(wp + (size_t)k * N); a0 += w * vp[k]; a1 += w * vp[4096 + k]; }
        *(LAS f32x2*)(red + (wave * 2 + 0) * 128 + 2 * lane) = a0; *(LAS f32x2*)(red + (wave * 2 + 1) * 128 + 2 * lane) = a1;
        __syncthreads();
        if (wave < 2) { float s0 = 0.f, s1 = 0.f;
#pragma unroll
            for (int w = 0; w < 8; ++w) { s0 += red[(w * 2 + wave) * 128 + lane]; s1 += red[(w * 2 + wave) * 128 + 64 + lane]; }
            float* op = wave ? o1 : o0; if (op) { op[lane] = s0 + bias[lane]; op[64 + lane] = s1 + bias[64 + lane]; } }
        __syncthreads();
    }
    { float* RC = (float*)(ws + WS_ROPE); float* RS = RC + (size_t)T * 64; const int* pos = (const int*)a.in[I_POS];
      for (int idx = gw * 64 + lane; idx < T * 64; idx += NGW * 64) { const int t = idx >> 6, i = idx & 63;
          const float inv = 1.0f / exp2f((float)i * (13.287712379549449f / 64.f)); const float ang = (float)pos[t] * inv;
          const double rev = (double)ang * 0.15915494309189535; const float fr = (float)(rev - __builtin_rint(rev));
          RC[idx] = __builtin_amdgcn_cosf(fr); RS[idx] = __builtin_amdgcn_sinf(fr); } }
    { LAS float* scr = (LAS float*)(lds + wave * WAVE_LDS);
      bf16_t* WinT = (bf16_t*)(ws + WS_WIN); bf16_t* WoutT = (bf16_t*)(ws + WS_WOUT); bf16_t* W13T = (bf16_t*)(ws + WS_W13); bf16_t* W2T = (bf16_t*)(ws + WS_W2);
      bf16_t* CW1K = (bf16_t*)(ws + WS_CW1K); bf16_t* CW1V = (bf16_t*)(ws + WS_CW1V);
      constexpr int I_IN = 32 * 89, I_O = 32 * 32, I_F1 = 32 * 88, I_F2 = 88 * 32, I_C1 = 64 * 4;
      constexpr int NITEMS = I_IN + I_O + 2 * I_F1 + I_F2 + 2 * I_C1;
      unsigned* qctr = (unsigned*)(ws + WS_BAR) + 3520;
      for (;;) { int it = 0; if (lane == 0) it = (int)atomicAdd(qctr, 1u); it = __builtin_amdgcn_readfirstlane(it); if (it >= NITEMS) break; int r = it;
          if (r < I_IN) { transpose_item(a.in[I_WIN], D, INW, WinT, 0, scr, r, lane); continue; } r -= I_IN;
          if (r < I_O) { transpose_item(a.in[I_WOUT], D, D, WoutT, 0, scr, r, lane, a.in[I_ONC], a.in[I_ONA]); continue; } r -= I_O;
          if (r < I_F1) { transpose_item(a.in[I_W1], D, DFF, W13T, 1, scr, r, lane); continue; } r -= I_F1;
          if (r < I_F1) { transpose_item(a.in[I_W3], D, DFF, W13T, 2, scr, r, lane); continue; } r -= I_F1;
          if (r < I_F2) { transpose_item(a.in[I_W2], DFF, D, W2T, 0, scr, r, lane); continue; } r -= I_F2;
          if (r < I_C1) { transpose_item(a.in[I_KW1], 4096, 256, CW1K, 0, scr, r, lane); continue; } r -= I_C1;
          transpose_item(a.in[I_VW1], 4096, 256, CW1V, 0, scr, r, lane); }
      u32x4* z = (u32x4*)(WinT + (size_t)INW * D); const int nz = (INWP - INW) * D / 8;
      for (int i = blockIdx.x * 512 + tid; i < nz; i += G * 512) z[i] = (u32x4){0u, 0u, 0u, 0u}; }
}

DI void norm_mod_rows(const float* src, const float* gain, const float* ada, int shi, int sci, bf16_t* dst, int gw, int NGW, int lane) {
    f32x4 gm[8], sh[8]; int bprev = -1;
    for (int m = gw; m < T; m += NGW) {
        const int b = m >> 14;
        if (b != bprev) { bprev = b;
#pragma unroll
            for (int j = 0; j < 8; ++j) { const int col = 4 * lane + 256 * j;
                gm[j] = *(const f32x4*)(gain + col) * (*(const f32x4*)(ada + b * 12288 + sci * 2048 + col) + 1.f); sh[j] = *(const f32x4*)(ada + b * 12288 + shi * 2048 + col); } }
        const f32x4* xr = (const f32x4*)(src + (size_t)m * D) + lane;
        f32x4 v[8]; float s = 0.f;
#pragma unroll
        for (int j = 0; j < 8; ++j) { v[j] = __builtin_nontemporal_load(xr + 64 * j); s += (v[j].x * v[j].x + v[j].y * v[j].y) + (v[j].z * v[j].z + v[j].w * v[j].w); }
        const float rstd = rsqrtf(wsum64(s) * (1.f / D) + EPS);
#pragma unroll
        for (int j = 0; j < 8; ++j) { const int col = 4 * lane + 256 * j;
            const f32x4 o = v[j] * rstd * gm[j] + sh[j];
            u32x2 w; w.x = pk2(o.x, o.y); w.y = pk2(o.z, o.w);
            *(u32x2*)(dst + (size_t)m * D + col) = w; }
    }
}

DI void bias13_rows(const bf16_t* W13T, const float* ada, float* bias13, int gw, int NGW, int lane) {
    for (int n = gw; n < 2 * DFF; n += NGW) {
        float s0 = 0.f, s1 = 0.f;
#pragma unroll
        for (int j = 0; j < 4; ++j) { const int k = 8 * (lane + 64 * j); const u32x4 w = *(const u32x4*)(W13T + (size_t)n * D + k);
#pragma unroll
            for (int e = 0; e < 4; ++e) { const float wa = __uint_as_float(w[e] << 16), wb = __uint_as_float(w[e] & 0xffff0000u);
                s0 += wa * ada[3 * 2048 + k + 2 * e] + wb * ada[3 * 2048 + k + 2 * e + 1];
                s1 += wa * ada[12288 + 3 * 2048 + k + 2 * e] + wb * ada[12288 + 3 * 2048 + k + 2 * e + 1]; } }
        s0 = wsum64(s0); s1 = wsum64(s1);
        if (lane == 0) { bias13[n] = s0; bias13[2 * DFF + n] = s1; }
    }
}

DI float dpp_x1(float v) { return __int_as_float(__builtin_amdgcn_update_dpp(0, __float_as_int(v), 0xB1, 0xF, 0xF, false)); }
DI float dpp_x2(float v) { return __int_as_float(__builtin_amdgcn_update_dpp(0, __float_as_int(v), 0x4E, 0xF, 0xF, false)); }
DI float dpp_r4(float v) { return __int_as_float(__builtin_amdgcn_update_dpp(0, __float_as_int(v), 0x124, 0xF, 0xF, false)); }
DI float dpp_r8(float v) { return __int_as_float(__builtin_amdgcn_update_dpp(0, __float_as_int(v), 0x128, 0xF, 0xF, false)); }
DI float row16_sum(float v) { v += dpp_x1(v); v += dpp_x2(v); v += dpp_r4(v); v += dpp_r8(v); return v; }
DI void conv_range(const Args& a, const bf16_t* CIN, bf16_t* Y, int tb, int te, int lane) {
    const float* cw = a.in[I_CONVW];
#pragma unroll 1
    for (int c2 = 0; c2 < 2; ++c2) {
        const int ch0 = 512 * c2 + 8 * lane;
        float w0[8], w1[8], w2[8], u1[8], u2[8];
#pragma unroll
        for (int e = 0; e < 8; ++e) { w0[e] = cw[ch0 + e]; w1[e] = cw[1024 + ch0 + e]; w2[e] = cw[2048 + ch0 + e]; u1[e] = 0.f; u2[e] = 0.f; }
#pragma unroll
        for (int back = 2; back >= 1; --back) {
            if ((tb & (S - 1)) >= back) {
                const bf16_t* rp = CIN + (size_t)(tb - back) * 4096;
                const u32x4 cc = *(const u32x4*)(rp + 1024 + ch0), hh = *(const u32x4*)(rp + 2048 + ch0);
#pragma unroll
                for (int e = 0; e < 4; ++e) { const float ca = __uint_as_float(cc[e] << 16), cb_ = __uint_as_float(cc[e] & 0xffff0000u), ha = __uint_as_float(hh[e] << 16), hb = __uint_as_float(hh[e] & 0xffff0000u);
                    if (back == 2) { u2[2 * e] = ca * ha; u2[2 * e + 1] = cb_ * hb; } else { u1[2 * e] = ca * ha; u1[2 * e + 1] = cb_ * hb; } }
            }
        }
#pragma unroll 4
        for (int t = tb; t < te; ++t) {
            if ((t & (S - 1)) == 0) {
#pragma unroll
                for (int e = 0; e < 8; ++e) { u1[e] = 0.f; u2[e] = 0.f; } }
            const bf16_t* rp = CIN + (size_t)t * 4096;
            const u32x4 bb = *(const u32x4*)(rp + ch0), cc = *(const u32x4*)(rp + 1024 + ch0), hh = *(const u32x4*)(rp + 2048 + ch0);
            float y[8]; float ss = 0.f;
#pragma unroll
            for (int e = 0; e < 4; ++e) {
                const float ca = __uint_as_float(cc[e] << 16), cb_ = __uint_as_float(cc[e] & 0xffff0000u), ha = __uint_as_float(hh[e] << 16), hb = __uint_as_float(hh[e] & 0xffff0000u);
                const float ba = __uint_as_float(bb[e] << 16), bbb = __uint_as_float(bb[e] & 0xffff0000u);
                const float ua = ca * ha, ub = cb_ * hb;
                y[2 * e] = ba * (w0[2 * e] * u2[2 * e] + w1[2 * e] * u1[2 * e] + w2[2 * e] * ua);
                y[2 * e + 1] = bbb * (w0[2 * e + 1] * u2[2 * e + 1] + w1[2 * e + 1] * u1[2 * e + 1] + w2[2 * e + 1] * ub);
                u2[2 * e] = u1[2 * e]; u2[2 * e + 1] = u1[2 * e + 1]; u1[2 * e] = ua; u1[2 * e + 1] = ub;
                ss += y[2 * e] * y[2 * e] + y[2 * e + 1] * y[2 * e + 1];
            }
            ss = row16_sum(ss);
            const float rstd = rsqrtf(ss * (1.f / 128.f) + EPS);
            u32x4 w; w.x = pk2(y[0] * rstd, y[1] * rstd); w.y = pk2(y[2] * rstd, y[3] * rstd);
            w.z = pk2(y[4] * rstd, y[5] * rstd); w.w = pk2(y[6] * rstd, y[7] * rstd);
            *(u32x4*)(Y + (size_t)t * D + ch0) = w;
        }
    }
}
DI int perm_slc(int p) { const int q = p & 31; return (p & 32) | (((q >> 2) & 1) << 4) | ((q >> 3) << 2) | (q & 3); }
DI int perm_w16(int p) { return (p & ~15) | (p & 3) | ((p & 4) << 1) | ((p & 8) >> 1); }
DI size_t k32_off(int n, int d) { return (size_t)(n >> 5) * 4096 + (d >> 4) * 512 + ((((d & 15) >> 3) * 32) + (n & 31)) * 8 + (d & 7); }
DI size_t k16_off(int s, int d) { return (size_t)(s >> 6) * 8192 + ((s >> 4) & 3) * 2048 + (d >> 5) * 512 + (s & 15) * 32 + (d & 31); }
DI unsigned fp8x2(float a, float b) { return (unsigned)__builtin_amdgcn_cvt_pk_fp8_f32(a, b, 0, false) & 0xffffu; }
DI bf16x8 fp8_frag(unsigned w0, unsigned w1) {
    u32x4 o;
    o.x = __builtin_bit_cast(unsigned, __builtin_amdgcn_cvt_scalef32_pk_bf16_fp8(w0, 1.0f, false)); o.y = __builtin_bit_cast(unsigned, __builtin_amdgcn_cvt_scalef32_pk_bf16_fp8(w0, 1.0f, true));
    o.z = __builtin_bit_cast(unsigned, __builtin_amdgcn_cvt_scalef32_pk_bf16_fp8(w1, 1.0f, false)); o.w = __builtin_bit_cast(unsigned, __builtin_amdgcn_cvt_scalef32_pk_bf16_fp8(w1, 1.0f, true));
    return __builtin_bit_cast(bf16x8, o);
}
DI size_t k8_off(int s_, int d) { return (size_t)(s_ >> 6) * 8192 + (((s_ >> 4) & 3) * 2 + (d >> 6)) * 1024 + ((((d & 31) >> 3) * 16) + (s_ & 15)) * 16 + ((d >> 5) & 1) * 8 + (d & 7); }
constexpr float QSCALE = 0.08838834764831845f * 1.4426950408889634f;
DI void normrope_item(const Args& a, unsigned char* ws, int tok, int lane) {
    const bf16_t* CIN = (const bf16_t*)(ws + WS_CONVIN); const bf16_t* KV6 = (const bf16_t*)(ws + WS_KV6);
    const int b = tok >> 14, s = tok & (S - 1), hsub = lane >> 4, l16 = lane & 15, d0 = 8 * l16;
    const float* RC = (const float*)(ws + WS_ROPE) + (size_t)tok * 64 + (d0 & 63); const float* RS = RC + (size_t)T * 64;
    const f32x4 c0 = *(const f32x4*)RC, c1 = *(const f32x4*)(RC + 4), s0 = *(const f32x4*)RS, s1 = *(const f32x4*)(RS + 4);
    const float cs[8] = {c0.x, c0.y, c0.z, c0.w, c1.x, c1.y, c1.z, c1.w};
    const float sgn = l16 < 8 ? -1.f : 1.f;
    const float sn[8] = {s0.x * sgn, s0.y * sgn, s0.z * sgn, s0.w * sgn, s1.x * sgn, s1.y * sgn, s1.z * sgn, s1.w * sgn};
#pragma unroll
    for (int p = 0; p < 3; ++p) {
        const bf16_t* src; const float* gain; float scale = 1.f; int kind;
        int head;
        if (p < 2) { head = 4 * p + hsub; kind = 0; src = CIN + (size_t)tok * 4096 + 3072 + head * 128 + d0; gain = a.in[I_QN]; scale = QSCALE; }
        else if (hsub < 2) { head = hsub; kind = 1; src = KV6 + ((size_t)(2 * 4 + b * 2 + head) * S + s) * 128 + d0; gain = a.in[I_KN] + 128; }
        else { head = hsub - 2; kind = 2; src = KV6 + ((size_t)(4 * 4 + b * 2 + head) * S + s) * 128 + d0; gain = a.in[I_KN] + 256; }
        const u32x4 raw = *(const u32x4*)src;
        const f32x4 g0 = *(const f32x4*)(gain + d0), g1 = *(const f32x4*)(gain + d0 + 4);
        const float gg[8] = {g0.x, g0.y, g0.z, g0.w, g1.x, g1.y, g1.z, g1.w};
        float x[8]; float ss = 0.f;
#pragma unroll
        for (int e = 0; e < 4; ++e) { x[2 * e] = __uint_as_float(raw[e] << 16); x[2 * e + 1] = __uint_as_float(raw[e] & 0xffff0000u); ss += x[2 * e] * x[2 * e] + x[2 * e + 1] * x[2 * e + 1]; }
        const float rstd = rsqrtf(row16_sum(ss) * (1.f / 128.f) + EPS);
        float o[8];
#pragma unroll
        for (int e = 0; e < 8; ++e) { const float y = x[e] * rstd * gg[e]; const float pr = dpp_r8(y); o[e] = (y * cs[e] + pr * sn[e]) * scale; }
        u32x4 wb; wb.x = pk2(o[0], o[1]); wb.y = pk2(o[2], o[3]); wb.z = pk2(o[4], o[5]); wb.w = pk2(o[6], o[7]);
        u32x2 w8; w8.x = fp8x2(o[0], o[1]) | (fp8x2(o[2], o[3]) << 16); w8.y = fp8x2(o[4], o[5]) | (fp8x2(o[6], o[7]) << 16);
        if (kind == 0) {
            *(u32x4*)((bf16_t*)(ws + WS_QR) + (size_t)tok * 1024 + head * 128 + d0) = wb;
            *(u32x2*)((unsigned char*)(ws + WS_QR8) + (size_t)tok * 1024 + head * 128 + d0) = w8;
        } else if (kind == 1) {
            *(u32x2*)((unsigned char*)(ws + WS_KSL) + (size_t)(b * 2 + head) * S * 128 + k8_off(s, d0)) = w8;
            *(u32x4*)((bf16_t*)(ws + WS_KSL32) + (size_t)(b * 2 + head) * S * 128 + k32_off(s, d0)) = wb;
        } else {
            *(u32x4*)((bf16_t*)(ws + WS_KWN) + (size_t)(b * 2 + head) * S * 128 + k32_off(s, d0)) = wb;
        }
    }
}
DI void vtrans_item(unsigned char* ws, int mode, int item, LAS unsigned char* scr, int lane) {
    const bf16_t* KV6 = (const bf16_t*)(ws + WS_KV6);
    const int bg = item >> 8, blk = item & 255;
    const bf16_t* src = KV6 + ((size_t)((mode == 1 ? 5 : 3) * 4 + bg) * S + 64 * blk) * 128;
#pragma unroll 4
    for (int i = 0; i < 16; ++i) { const int c = lane + 64 * i, key = c >> 4, dc = c & 15;
        *(LAS u32x4*)(scr + key * 272 + dc * 16) = *(const u32x4*)(src + (size_t)key * 128 + dc * 8); }
    LDS_WAIT();
    if (mode) {
        bf16_t* dstb = (bf16_t*)(ws + (mode == 1 ? WS_VWNT : WS_VSL32)) + ((size_t)bg * 256 + blk) * 8192;
#pragma unroll 4
        for (int i = 0; i < 16; ++i) { const int c = lane + 64 * i, d = c >> 3, pc = c & 7;
            unsigned w[4];
#pragma unroll
            for (int e = 0; e < 4; ++e) { const int p0 = 8 * pc + 2 * e, k0 = perm_w16(p0), k1 = perm_w16(p0 + 1);
                const unsigned lo = *(const LAS bf16_t*)(scr + k0 * 272 + d * 2), hi = *(const LAS bf16_t*)(scr + k1 * 272 + d * 2); w[e] = lo | (hi << 16); }
            const size_t off = (size_t)(pc >> 2) * 4096 + ((pc >> 1) & 1) * 2048 + (d >> 5) * 512 + ((pc & 1) * 32 + (d & 31)) * 8;
            *(u32x4*)(dstb + off) = (u32x4){w[0], w[1], w[2], w[3]}; }
    } else {
        unsigned char* dstb = (unsigned char*)(ws + WS_VSLT) + ((size_t)bg * 256 + blk) * 8192;
#pragma unroll 4
        for (int i = 0; i < 16; ++i) { const int c = lane + 64 * i, d = c >> 3, pc = c & 7;
            unsigned w[4];
#pragma unroll
            for (int e = 0; e < 4; ++e) { const int p0 = 8 * pc + 2 * e, k0 = perm_slc(p0), k1 = perm_slc(p0 + 1);
                const float lo = bf2f(*(const LAS bf16_t*)(scr + k0 * 272 + d * 2)), hi = bf2f(*(const LAS bf16_t*)(scr + k1 * 272 + d * 2)); w[e] = fp8x2(lo, hi); }
            const size_t off = (size_t)((pc >> 2) * 4 + (d >> 5)) * 1024 + ((pc & 3) * 16 + (d & 15)) * 16 + ((d >> 4) & 1) * 8;
            *(u32x2*)(dstb + off) = (u32x2){w[0] | (w[1] << 16), w[2] | (w[3] << 16)}; }
    }
    LDS_WAIT();
}

DI void cmp2_row(const Args& a, const unsigned char* ws, const LAS float* w2s, int kv, int m, int lane) {
    const int bg = m >> 10, n = m & 1023;
    bf16_t* KC = (bf16_t*)(ws + WS_KCMP) + (size_t)bg * 131072; bf16_t* VT = (bf16_t*)(ws + WS_VCMPT) + (size_t)bg * 131072;
    float o1 = 0.f, o2 = 0.f;
    if (n < 1023) {
        const float* hid = (const float*)(ws + WS_HID) + ((size_t)kv * 4096 + m) * 256;
        const f32x4 hv4 = *(const f32x4*)(hid + 4 * lane);
#pragma unroll 4
        for (int h4 = 0; h4 < 64; ++h4) {
#pragma unroll
            for (int e = 0; e < 4; ++e) { const float hv = __int_as_float(__builtin_amdgcn_readlane(__float_as_int(hv4[e]), h4));
                o1 += hv * w2s[(4 * h4 + e) * 128 + lane]; o2 += hv * w2s[(4 * h4 + e) * 128 + 64 + lane]; } }
    }
    if (kv == 0) {
        float ss = wsum64(o1 * o1 + o2 * o2); const float rstd = rsqrtf(ss * (1.f / 128.f) + EPS);
        const float* gain = a.in[I_KN]; o1 *= rstd * gain[lane]; o2 *= rstd * gain[64 + lane];
        const int b = bg >> 1, tok = b * S + ((n < 1023) ? 16 * n + 31 : 0);
        const float* RC = (const float*)(ws + WS_ROPE) + (size_t)tok * 64; const float* RS = RC + (size_t)T * 64;
        const float c = RC[lane], sn = RS[lane];
        const float r1 = o1 * c - o2 * sn, r2 = o2 * c + o1 * sn;
        KC[k32_off(n, lane)] = (bf16_t)(pk2(r1, 0.f) & 0xffffu); KC[k32_off(n, 64 + lane)] = (bf16_t)(pk2(r2, 0.f) & 0xffffu);
    } else {
        const int pp = perm_w16(n & 15);
        const size_t base = (size_t)(n >> 5) * 4096 + ((n >> 4) & 1) * 2048 + ((pp >> 3) * 32 + (lane & 31)) * 8 + (pp & 7);
        VT[base + (lane >> 5) * 512] = (bf16_t)(pk2(o1, 0.f) & 0xffffu);
        VT[base + (2 + (lane >> 5)) * 512] = (bf16_t)(pk2(o2, 0.f) & 0xffffu);
    }
}
DI void cmp2_phase(const Args& a, const unsigned char* ws, LAS unsigned char* lds, int tid, int wave, int G) {
    const int lane = tid & 63;
    for (int kv = 0; kv < 2; ++kv) {
        if (G > 1 && (int)(blockIdx.x & 1) != kv) continue;
        const int nb = G > 1 ? (G + 1 - kv) / 2 : 1, bi = G > 1 ? (int)(blockIdx.x >> 1) : 0;
        const float* w2 = a.in[kv ? I_VW2 : I_KW2];
        __syncthreads();
        for (int i = tid; i < 8192; i += 512) *(LAS f32x4*)(lds + i * 16) = *(const f32x4*)(w2 + 4 * i);
        __syncthreads();
        for (int m = bi * 8 + wave; m < 4096; m += nb * 8) cmp2_row(a, ws, (const LAS float*)lds, kv, m, lane);
    }
    __syncthreads();
}

#define MFMA32(a, b, c) __builtin_amdgcn_mfma_f32_32x32x16_bf16((a), (b), (c), 0, 0, 0)
#define MFMA16(a, b, c) __builtin_amdgcn_mfma_f32_16x16x32_bf16((a), (b), (c), 0, 0, 0)
#define MFMA16F8(a, b, c) __builtin_amdgcn_mfma_f32_16x16x32_fp8_fp8((a), (b), (c), 0, 0, 0)
DI long mk64(unsigned lo, unsigned hi) { return (long)(((unsigned long long)hi << 32) | lo); }
DI void ld8(bf16x8 (&k)[8], const bf16_t* p) {
#pragma unroll
    for (int i = 0; i < 8; ++i) k[i] = *(const bf16x8*)(p + i * 512);
}
DI f32x16 qk32(const bf16x8 (&k)[8], const bf16x8 (&q)[8]) {
    f32x16 s;
#pragma unroll
    for (int i = 0; i < 16; ++i) s[i] = 0.f;
    __builtin_amdgcn_s_setprio(1);
#pragma unroll
    for (int ks = 0; ks < 8; ++ks) s = MFMA32(k[ks], q[ks], s);
    __builtin_amdgcn_s_setprio(0);
    return s;
}
DI void pass1_tile(const bf16_t* Kb, int tile, int tnext, bf16x8 (&kc)[8], bf16x8 (&kn)[8], const bf16x8 (&q)[8], int limlo, int limhi, int lofs, int h, float& l) {
    ld8(kn, Kb + (size_t)tnext * 4096 + lofs);
    const int key0 = 32 * tile; const f32x16 s = qk32(kc, q);
#pragma unroll
    for (int i = 0; i < 16; ++i) { const int key = key0 + 8 * (i >> 2) + 4 * h + (i & 3); l += (key <= limhi && key > limlo) ? __builtin_amdgcn_exp2f(s[i]) : 0.f; }
}
DI float attn_pass1(const bf16_t* Kb, int tlo, int thi, const bf16x8 (&q)[8], int limlo, int limhi, int lofs, int h) {
    float l = 0.f; bf16x8 ka[8], kb[8]; ld8(ka, Kb + (size_t)tlo * 4096 + lofs);
    int tile = tlo;
#pragma unroll 1
    for (; tile < thi; tile += 2) {
        pass1_tile(Kb, tile, tile + 1, ka, kb, q, limlo, limhi, lofs, h, l);
        pass1_tile(Kb, tile + 1, tile + 2 <= thi ? tile + 2 : tile + 1, kb, ka, q, limlo, limhi, lofs, h, l);
    }
    if (tile == thi) pass1_tile(Kb, tile, tile, ka, kb, q, limlo, limhi, lofs, h, l);
    return l + __shfl_xor(l, 32);
}
template <bool IMP, bool PV>
DI void pass2_tile(const bf16_t* Kb, const bf16_t* VTb, int tile, int tnext, bf16x8 (&kc)[8], bf16x8 (&kn)[8], const bf16x8 (&q)[8], int limlo, int limhi, float inv, float gate,
                   f32x16 (&O)[4], LAS float* imp, LAS float* car, int n, int h, int lofs, float& l) {
    bf16x8 vf[8]; if (PV) ld8(vf, VTb + (size_t)tile * 4096 + lofs);
    ld8(kn, Kb + (size_t)tnext * 4096 + lofs);
    const int key0 = 32 * tile; const f32x16 s = qk32(kc, q);
    const float pscale = IMP ? inv : inv * gate, pgate = IMP ? gate : 1.f;
    float p[16];
#pragma unroll
    for (int i = 0; i < 16; ++i) { const int key = key0 + 8 * (i >> 2) + 4 * h + (i & 3); p[i] = (key <= limhi && key > limlo) ? __builtin_amdgcn_exp2f(s[i]) * pscale : 0.f; l += p[i]; }
    if (IMP) {
#pragma unroll
        for (int i4 = 0; i4 < 4; ++i4) {
            float P4 = (p[4 * i4] + p[4 * i4 + 1]) + (p[4 * i4 + 2] + p[4 * i4 + 3]), pl = p[4 * i4 + 3];
            P4 += dpp_x1(P4); P4 += dpp_x2(P4); pl += dpp_x1(pl); pl += dpp_x2(pl);
            if ((n & 3) == 0) { const int j = 8 * tile + 2 * i4 + h, ql = n >> 2; imp[ql * 256 + j] = P4; if (j + 1 < 256) car[ql * 256 + j + 1] = pl; }
        }
    }
    if (PV) {
#pragma unroll
        for (int u = 0; u < 2; ++u) {
            u32x4 pw; pw.x = pk2(p[8 * u] * pgate, p[8 * u + 1] * pgate); pw.y = pk2(p[8 * u + 2] * pgate, p[8 * u + 3] * pgate);
            pw.z = pk2(p[8 * u + 4] * pgate, p[8 * u + 5] * pgate); pw.w = pk2(p[8 * u + 6] * pgate, p[8 * u + 7] * pgate);
            const bf16x8 pb = __builtin_bit_cast(bf16x8, pw);
            __builtin_amdgcn_s_setprio(1);
#pragma unroll
            for (int dt = 0; dt < 4; ++dt) O[dt] = MFMA32(vf[4 * u + dt], pb, O[dt]);
            __builtin_amdgcn_s_setprio(0);
        }
    }
}
template <bool IMP, bool PV>
DI float attn_pass2(const bf16_t* Kb, const bf16_t* VTb, int tlo, int thi, const bf16x8 (&q)[8], int limlo, int limhi, float inv, float gate,
                   f32x16 (&O)[4], LAS float* imp, LAS float* car, int n, int h, int lofs) {
    float l = 0.f;
    bf16x8 ka[8], kb[8]; ld8(ka, Kb + (size_t)tlo * 4096 + lofs);
    int tile = tlo;
#pragma unroll 1
    for (; tile < thi; tile += 2) {
        pass2_tile<IMP, PV>(Kb, VTb, tile, tile + 1, ka, kb, q, limlo, limhi, inv, gate, O, imp, car, n, h, lofs, l);
        pass2_tile<IMP, PV>(Kb, VTb, tile + 1, tile + 2 <= thi ? tile + 2 : tile + 1, kb, ka, q, limlo, limhi, inv, gate, O, imp, car, n, h, lofs, l);
    }
    if (tile == thi) pass2_tile<IMP, PV>(Kb, VTb, tile, tile, ka, kb, q, limlo, limhi, inv, gate, O, imp, car, n, h, lofs, l);
    return l;
}

DI void attn_item(const Args& a, const unsigned char* ws, LAS unsigned char* wl, int bg, int tile8, int lane) {
    const bf16_t* QR = (const bf16_t*)(ws + WS_QR); const float* GL = (const float*)(ws + WS_GL);
    const bf16_t* KC = (const bf16_t*)(ws + WS_KCMP) + (size_t)bg * 131072; const bf16_t* VCT = (const bf16_t*)(ws + WS_VCMPT) + (size_t)bg * 131072;
    const bf16_t* KW = (const bf16_t*)(ws + WS_KWN) + (size_t)bg * S * 128; const bf16_t* VWT = (const bf16_t*)(ws + WS_VWNT) + (size_t)bg * S * 128;
    const bf16_t* KS32 = (const bf16_t*)(ws + WS_KSL32) + (size_t)bg * S * 128; const bf16_t* VS32 = (const bf16_t*)(ws + WS_VSL32) + (size_t)bg * S * 128;
    const unsigned char* KSLb = (const unsigned char*)(ws + WS_KSL) + (size_t)bg * S * 128; const unsigned char* VSLb = (const unsigned char*)(ws + WS_VSLT) + (size_t)bg * S * 128;
    bf16_t* Y = (bf16_t*)(ws + WS_Y);
    LAS float* IMPL = (LAS float*)wl; LAS float* CARL = (LAS float*)(wl + 8192); LAS float* OST = (LAS float*)wl; LAS int* SEL = (LAS int*)(wl + 16896); LAS float* LR = (LAS float*)(wl + 17408);
    const int b = bg >> 1, g = bg & 1, t0 = 8 * tile8;
    const int cur = t0 >> 6, nrest = cur >= 16 ? 13 : (cur > 2 ? cur - 2 : 0);
    const size_t tok0 = (size_t)b * S + t0;
    const int n = lane & 31, h = lane >> 5, ql = n >> 2, r = n & 3, lofs = lane * 8;
    const int tq = t0 + ql; const size_t tok = tok0 + ql;
    const bool has_cmp = t0 + 7 >= 31;
    const int cthi = has_cmp ? ((t0 + 7 - 31) >> 4) >> 5 : 0; const int clim = (tq >= 31) ? ((tq - 31) >> 4) : -1;
    float inv_c = 0.f;
    {
        bf16x8 q[8];
        const bf16_t* qp = QR + tok * 1024 + (4 * g + r) * 128 + 8 * h;
#pragma unroll
        for (int ks = 0; ks < 8; ++ks) q[ks] = *(const bf16x8*)(qp + 16 * ks);
        if (has_cmp) {
            const float l = attn_pass1(KC, 0, cthi, q, -1, clim, lofs, h);
            inv_c = l > 0.f ? 1.f / l : 0.f;
            if (cur >= 16) { f32x16 Od[4]; (void)attn_pass2<true, false>(KC, VCT, 0, cthi, q, -1, clim, inv_c, 1.f, Od, IMPL, CARL, n, h, lofs); }
        }
        LDS_WAIT();
        if (cur >= 16) {
#pragma unroll 1
            for (int qi = 0; qi < 8; ++qi) {
                LAS int* sel = SEL + qi * 16;
                int vb[4];
#pragma unroll
                for (int i = 0; i < 4; ++i) { const int j = lane + 64 * i; vb[i] = (j >= 1 && j <= cur - 2) ? __float_as_int(fmaxf(IMPL[qi * 256 + j] + CARL[qi * 256 + j], 0.f)) : -1; }
                int Tb = 0;
#pragma unroll 1
                for (int bit = 30; bit >= 0; --bit) {
                    const int cand = Tb | (1 << bit); int c = 0;
#pragma unroll
                    for (int i = 0; i < 4; ++i) c += __builtin_popcountll(__ballot(vb[i] >= cand));
                    if (c >= 13) Tb = cand;
                }
                int base = 0;
#pragma unroll
                for (int i = 0; i < 4; ++i) { const unsigned long long m = __ballot(vb[i] > Tb);
                    const int pre = __builtin_amdgcn_mbcnt_hi((unsigned)(m >> 32), __builtin_amdgcn_mbcnt_lo((unsigned)m, 0u));
                    if (vb[i] > Tb) sel[base + pre] = lane + 64 * i;
                    base += __builtin_popcountll(m); }
                const int need = 13 - base; int taken = 0;
#pragma unroll
                for (int i = 0; i < 4; ++i) { const unsigned long long m = __ballot(vb[i] == Tb);
                    const int pre = __builtin_amdgcn_mbcnt_hi((unsigned)(m >> 32), __builtin_amdgcn_mbcnt_lo((unsigned)m, 0u));
                    if (vb[i] == Tb && taken + pre < need) sel[base + taken + pre] = lane + 64 * i;
                    taken += __builtin_popcountll(m); }
            }
        } else if (lane < 13) {
#pragma unroll
            for (int qi = 0; qi < 8; ++qi) SEL[qi * 16 + lane] = lane + 1;
        }
        LDS_WAIT();
    }
    if (nrest > 0) {
        const int n16 = lane & 15, kq = lane >> 4, r16 = n16 & 3, lo16 = lane * 16;
        const int total = 8 * nrest;
        const unsigned char* qbase = (const unsigned char*)(ws + WS_QR8) + tok0 * 1024 + (4 * g + r16) * 128 + 8 * kq;
        u32x4 kA[8], vA[8]; u32x2 q16[4];
        int jcur = __builtin_amdgcn_readfirstlane(SEL[0]);
        {
            const unsigned char* Kp = KSLb + (size_t)jcur * 8192 + lo16; const unsigned char* Vp = VSLb + (size_t)jcur * 8192 + lo16;
#pragma unroll
            for (int i = 0; i < 8; ++i) kA[i] = *(const u32x4*)(Kp + i * 1024);
#pragma unroll
            for (int i = 0; i < 8; ++i) vA[i] = *(const u32x4*)(Vp + i * 1024);
#pragma unroll
            for (int ks = 0; ks < 4; ++ks) q16[ks] = *(const u32x2*)(qbase + 32 * ks);
        }
        f32x4 Os[8]; float l = 0.f;
#pragma unroll
        for (int dt = 0; dt < 8; ++dt) Os[dt] = (f32x4){0.f, 0.f, 0.f, 0.f};
        int qi = 0, si = 0;
#pragma unroll 1
        for (int f = 0; f < total; ++f) {
            int sn = si + 1, qn = qi; if (sn == nrest) { sn = 0; qn = qi + 1; }
            const bool hasn = f + 1 < total, lastb = (si == nrest - 1);
            const int jn = hasn ? __builtin_amdgcn_readfirstlane(SEL[qn * 16 + sn]) : jcur;
            f32x4 s[4];
            __builtin_amdgcn_s_setprio(1);
#pragma unroll
            for (int kt = 0; kt < 4; ++kt) { s[kt] = (f32x4){0.f, 0.f, 0.f, 0.f};
#pragma unroll
                for (int kp = 0; kp < 2; ++kp) { const u32x4 rw = kA[kt * 2 + kp];
                    s[kt] = MFMA16F8(mk64(rw.x, rw.y), mk64(q16[2 * kp].x, q16[2 * kp].y), s[kt]); s[kt] = MFMA16F8(mk64(rw.z, rw.w), mk64(q16[2 * kp + 1].x, q16[2 * kp + 1].y), s[kt]); } }
            __builtin_amdgcn_s_setprio(0);
            { const unsigned char* Kp = KSLb + (size_t)jn * 8192 + lo16;
#pragma unroll
                for (int i = 0; i < 8; ++i) kA[i] = *(const u32x4*)(Kp + i * 1024); }
            if (lastb && hasn) {
#pragma unroll
                for (int ks = 0; ks < 4; ++ks) q16[ks] = *(const u32x2*)(qbase + (size_t)qn * 1024 + 32 * ks);
            }
#pragma unroll
            for (int kt = 0; kt < 4; ++kt)
#pragma unroll
                for (int e = 0; e < 4; ++e) { const float ev = __builtin_amdgcn_exp2f(s[kt][e]); s[kt][e] = ev; l += ev; }
#pragma unroll
            for (int u = 0; u < 2; ++u) {
                u32x4 pw; pw.x = pk2(s[2 * u][0], s[2 * u][1]); pw.y = pk2(s[2 * u][2], s[2 * u][3]); pw.z = pk2(s[2 * u + 1][0], s[2 * u + 1][1]); pw.w = pk2(s[2 * u + 1][2], s[2 * u + 1][3]);
                const bf16x8 pb = __builtin_bit_cast(bf16x8, pw);
                __builtin_amdgcn_s_setprio(1);
#pragma unroll
                for (int dp = 0; dp < 4; ++dp) { const u32x4 rw = vA[u * 4 + dp];
                    Os[2 * dp] = MFMA16(fp8_frag(rw.x, rw.y), pb, Os[2 * dp]); Os[2 * dp + 1] = MFMA16(fp8_frag(rw.z, rw.w), pb, Os[2 * dp + 1]); }
                __builtin_amdgcn_s_setprio(0);
            }
            { const unsigned char* Vp = VSLb + (size_t)jn * 8192 + lo16;
#pragma unroll
                for (int i = 0; i < 8; ++i) vA[i] = *(const u32x4*)(Vp + i * 1024); }
            if (lastb) {
                l += __shfl_xor(l, 16); l += __shfl_xor(l, 32);
                if (n16 < 4) { LAS float* op = OST + (qi * 4 + r16) * 132 + 4 * kq;
#pragma unroll
                    for (int dt = 0; dt < 8; ++dt) *(LAS f32x4*)(op + 16 * dt) = Os[dt];
                    if (kq == 0) LR[qi * 4 + r16] = l; }
#pragma unroll
                for (int dt = 0; dt < 8; ++dt) Os[dt] = (f32x4){0.f, 0.f, 0.f, 0.f};
                l = 0.f;
            }
            si = sn; qi = qn; jcur = jn;
        }
    } else {
#pragma unroll
        for (int i = 0; i < 17; ++i) { const int idx = lane + 64 * i; if (idx < 32 * 132 / 4) *(LAS f32x4*)(OST + 4 * idx) = (f32x4){0.f, 0.f, 0.f, 0.f}; }
        if (lane < 32) LR[lane] = 0.f;
    }
    LDS_WAIT();
    {
        bf16x8 q[8];
        const bf16_t* qp = QR + tok * 1024 + (4 * g + r) * 128 + 8 * h;
#pragma unroll
        for (int ks = 0; ks < 8; ++ks) q[ks] = *(const bf16x8*)(qp + 16 * ks);
        const float* glp = GL + tok * 24 + (4 * g + r) * 3;
        const float g0 = sigmoidf_(glp[0]), g1 = sigmoidf_(glp[1]), g2 = sigmoidf_(glp[2]);
        f32x16 O[4];
#pragma unroll
        for (int dt = 0; dt < 4; ++dt)
#pragma unroll
            for (int i = 0; i < 16; ++i) O[dt][i] = 0.f;
        {
            const int lo_key = t0 - 511 > 0 ? t0 - 511 : 0; const int tlo = lo_key >> 5, thi = (t0 + 7) >> 5;
            float l = attn_pass2<false, true>(KW, VWT, tlo, thi, q, tq - 512, tq, 1.f, 1.f, O, nullptr, nullptr, n, h, lofs);
            l += __shfl_xor(l, 32);
            const float sc = g2 / l;
#pragma unroll
            for (int dt = 0; dt < 4; ++dt)
#pragma unroll
                for (int i = 0; i < 16; ++i) O[dt][i] *= sc;
        }
        if (has_cmp) (void)attn_pass2<false, true>(KC, VCT, 0, cthi, q, -1, clim, inv_c, g0, O, nullptr, nullptr, n, h, lofs);
        {
            const int a_lo = 0, a_hi = cur >= 2 ? 1 : 2 * cur + 1, b_lo = 2 * cur - 2, b_hi = 2 * cur + 1; const bool two = cur >= 2;
            float lf = attn_pass1(KS32, a_lo, a_hi, q, -1, tq, lofs, h);
            if (two) lf += attn_pass1(KS32, b_lo, b_hi, q, -1, tq, lofs, h);
            const float lt = lf + LR[n];
            const float sc = g1 / lt;
            (void)attn_pass2<false, true>(KS32, VS32, a_lo, a_hi, q, -1, tq, 1.f, sc, O, nullptr, nullptr, n, h, lofs);
            if (two) (void)attn_pass2<false, true>(KS32, VS32, b_lo, b_hi, q, -1, tq, 1.f, sc, O, nullptr, nullptr, n, h, lofs);
            float ss = 0.f;
#pragma unroll
            for (int dt = 0; dt < 4; ++dt)
#pragma unroll
                for (int i4 = 0; i4 < 4; ++i4) { const f32x4 pr = *(const LAS f32x4*)(OST + n * 132 + 32 * dt + 8 * i4 + 4 * h);
#pragma unroll
                    for (int e = 0; e < 4; ++e) { const float v = O[dt][4 * i4 + e] + pr[e] * sc; O[dt][4 * i4 + e] = v; ss += v * v; } }
            ss += __shfl_xor(ss, 32);
            const float rstd = rsqrtf(ss * (1.f / 128.f) + EPS);
            LDS_WAIT();
#pragma unroll
            for (int dt = 0; dt < 4; ++dt)
#pragma unroll
                for (int i4 = 0; i4 < 4; ++i4)
                    *(LAS f32x4*)(OST + n * 132 + 32 * dt + 8 * i4 + 4 * h) = (f32x4){O[dt][4 * i4] * rstd, O[dt][4 * i4 + 1] * rstd, O[dt][4 * i4 + 2] * rstd, O[dt][4 * i4 + 3] * rstd};
        }
        LDS_WAIT();
#pragma unroll 2
        for (int q8 = 0; q8 < 8; ++q8) { const int e = lane * 8, rr = e >> 7, d = e & 127; const LAS float* op = OST + (q8 * 4 + rr) * 132 + d;
            const f32x4 v0 = *(const LAS f32x4*)op, v1 = *(const LAS f32x4*)(op + 4);
            u32x4 w; w.x = pk2(v0.x, v0.y); w.y = pk2(v0.z, v0.w); w.z = pk2(v1.x, v1.y); w.w = pk2(v1.z, v1.w);
            *(u32x4*)(Y + (tok0 + q8) * D + 1024 + 4 * g * 128 + e) = w; }
    }
    LDS_WAIT();
}

__global__ void __launch_bounds__(512, 2) hymba_fwd(Args a) {
    extern __shared__ __attribute__((aligned(16))) unsigned char lds_raw[];
    LAS unsigned char* lds = (LAS unsigned char*)lds_raw;
    cg::grid_group grid = cg::this_grid();
    const int tid0 = threadIdx.x, wave = __builtin_amdgcn_readfirstlane(tid0 >> 6), G = gridDim.x;
    const int gw = blockIdx.x * 8 + wave, NGW = G * 8;
    unsigned char* ws = a.ws;
    float* ADA = (float*)(ws + WS_ADA);
    bf16_t* XN = (bf16_t*)(ws + WS_XN);
    volatile LAS unsigned* bst = (volatile LAS unsigned*)(lds + 8 * WAVE_LDS);
    if (tid0 < 16) bst[tid0] = 0u;
    __syncthreads();
    const XcdBarrier xbar = xcd_barrier_post((unsigned*)(ws + WS_BAR), bst);

    { const int tid = opaque(tid0); p0_prologue(a, lds, tid, tid & 63, wave, G); }
    grid.sync();
    { const int lane = opaque(tid0) & 63;
      norm_mod_rows(a.in[I_X], a.in[I_NMIX], ADA, 0, 1, XN, gw, NGW, lane);
      bias13_rows((const bf16_t*)(ws + WS_W13), ADA, (float*)(ws + WS_BIAS13), gw, NGW, lane);
      float* sq = (float*)(ws + WS_SUMSQ); for (int i = blockIdx.x * 512 + opaque(tid0); i < T; i += G * 512) sq[i] = 0.f; }
    xcd_barrier(xbar);
    {
        pg8::Gemm g{XN, (const bf16_t*)(ws + WS_WIN), T, INWP, D, D}; pg8::StaticOrder so; so.init(T, INWP, G, (int)blockIdx.x, 4);
        pg8::EpiProj E{(bf16_t*)(ws + WS_CONVIN), (bf16_t*)(ws + WS_KV6), (float*)(ws + WS_GL)};
        pg8::gemm_phase<pg8::EpiProj, pg8::StaticOrder, true>(lds, g, so, E);
    }
    xcd_barrier(xbar);
    {
        const int NGEMM = (G >= 64) ? 32 : 0;
        if ((int)blockIdx.x < NGEMM) {
            const int kv = blockIdx.x >> 4;
            pg8::Gemm g{(const bf16_t*)(ws + WS_KV6) + (size_t)kv * 4 * S * 128, (const bf16_t*)(ws + (kv ? WS_CW1V : WS_CW1K)), 4096, 256, 4096, 2048};
            pg8::OneUnit ou{(int)(blockIdx.x & 15)};
            pg8::EpiHid E{(float*)(ws + WS_HID) + (size_t)kv * 4096 * 256, (const float*)(ws + WS_CB1) + kv * 256};
            pg8::gemm_phase<pg8::EpiHid, pg8::OneUnit, false>(lds, g, ou, E);
        } else {
            const int ew = (blockIdx.x - NGEMM) * 8 + wave, NEW = (G - NGEMM) * 8, lane = opaque(tid0) & 63;
            LAS unsigned char* wl = lds + wave * WAVE_LDS;
            conv_range(a, (const bf16_t*)(ws + WS_CONVIN), (bf16_t*)(ws + WS_Y), (int)((long)ew * T / NEW), (int)((long)(ew + 1) * T / NEW), lane);
            for (int it = ew; it < T; it += NEW) normrope_item(a, ws, it, lane);
            for (int it = ew; it < 3072; it += NEW) vtrans_item(ws, it >> 10, it & 1023, wl, lane);
        }
        if (NGEMM == 0) {
            for (int u = blockIdx.x; u < 32; u += G) { const int kv = u >> 4;
                pg8::Gemm g{(const bf16_t*)(ws + WS_KV6) + (size_t)kv * 4 * S * 128, (const bf16_t*)(ws + (kv ? WS_CW1V : WS_CW1K)), 4096, 256, 4096, 2048};
                pg8::OneUnit ou{u & 15}; pg8::EpiHid E{(float*)(ws + WS_HID) + (size_t)kv * 4096 * 256, (const float*)(ws + WS_CB1) + kv * 256};
                __syncthreads();
                pg8::gemm_phase<pg8::EpiHid, pg8::OneUnit, false>(lds, g, ou, E); }
        }
    }
    xcd_barrier(xbar);
    cmp2_phase(a, ws, lds, opaque(tid0), wave, G);
    xcd_barrier(xbar);
    {
        LAS unsigned char* wl = lds + wave * WAVE_LDS;
        unsigned* heads = (unsigned*)(ws + WS_BAR) + 3584;
        const int bg0 = (int)(blockIdx.x & 3);
#pragma unroll 1
        for (int sidx = 0; sidx < 4; ++sidx) {
            const int bg = (bg0 + sidx) & 3;
#pragma unroll 1
            for (;;) {
                int it = 0; if ((tid0 & 63) == 0) it = (int)atomicAdd(heads + 64 * bg, 1u); it = __builtin_amdgcn_readfirstlane(it);
                if (it >= 2048) break;
                attn_item(a, ws, wl, bg, 2047 - it, opaque(tid0) & 63);
            }
        }
    }
    xcd_barrier(xbar);
    {
        pg8::Gemm g{(const bf16_t*)(ws + WS_Y), (const bf16_t*)(ws + WS_WOUT), T, D, D, D}; pg8::StaticOrder so; so.init(T, D, G, (int)blockIdx.x, 4);
        pg8::EpiRes2 E{a.in[I_X], (bf16_t*)(ws + WS_X1B), ADA + 2 * 2048, a.in[I_NFFN], ADA + 4 * 2048, XN, (float*)(ws + WS_SUMSQ)};
        pg8::gemm_phase<pg8::EpiRes2, pg8::StaticOrder, true>(lds, g, so, E);
    }
    xcd_barrier(xbar);
    {
        pg8::Gemm g{XN, (const bf16_t*)(ws + WS_W13), T, 2 * DFF, D, D}; pg8::StaticOrder so; so.init(T, 2 * DFF, G, (int)blockIdx.x, 4);
        pg8::EpiSwiGLU E{(bf16_t*)(ws + WS_ACT), (const float*)(ws + WS_SUMSQ), (const float*)(ws + WS_BIAS13)};
        pg8::gemm_phase<pg8::EpiSwiGLU, pg8::StaticOrder, true>(lds, g, so, E);
    }
    xcd_barrier(xbar);
    {
        pg8::Gemm g{(const bf16_t*)(ws + WS_ACT), (const bf16_t*)(ws + WS_W2), T, D, DFF, DFF}; pg8::StaticOrder so; so.init(T, D, G, (int)blockIdx.x, 2);
        pg8::EpiRes E{(const bf16_t*)(ws + WS_X1B), a.out, ADA + 5 * 2048};
        pg8::gemm_phase<pg8::EpiRes, pg8::StaticOrder, true>(lds, g, so, E);
    }
}

extern "C" void kernel_launch(void* const* d_in, const int* in_sizes, int n_in, void* d_out, int out_size, void* d_ws, size_t ws_size, hipStream_t stream) {
    static int grid = 0;
    if (grid == 0) {
        if (n_in != 25 || out_size != T * D || ws_size < WS_END) { fprintf(stderr, "kernel_launch: unexpected shapes (n_in %d, out %d, ws %zu)\n", n_in, out_size, ws_size); grid = -1; return; }
        int dev = 0, cus = 0, per_cu = 0;
        hipGetDevice(&dev); hipDeviceGetAttribute(&cus, hipDeviceAttributeMultiprocessorCount, dev);
        hipFuncSetAttribute((const void*)hymba_fwd, hipFuncAttributeMaxDynamicSharedMemorySize, LDS_BYTES);
        if (hipOccupancyMaxActiveBlocksPerMultiprocessor(&per_cu, (const void*)hymba_fwd, 512, LDS_BYTES) != hipSuccess || per_cu < 1) per_cu = 1;
        (void)hipGetLastError();
        if (per_cu > 1) per_cu = 1;
        grid = cus * per_cu;
    }
    if (grid < 0) return;
    if (hipMemsetAsync((char*)d_ws + WS_BAR, 0, 16384, stream) != hipSuccess) { fprintf(stderr, "kernel_launch: memset of the barrier words failed\n"); return; }
    Args a{};
    for (int i = 0; i < 25; ++i) a.in[i] = (const float*)d_in[i];
    a.out = (float*)d_out; a.ws = (unsigned char*)d_ws;
    void* args[] = {&a};
    hipError_t e = hipLaunchCooperativeKernel((const void*)hymba_fwd, dim3(grid), dim3(512), args, LDS_BYTES, stream);
    if (e != hipSuccess) fprintf(stderr, "cooperative launch failed: %s (grid %d)\n", hipGetErrorString(e), grid);
}
```

```cpp
#include <hip/hip_runtime.h>
#include <hip/hip_cooperative_groups.h>
#include <cstdio>
#include <cstdint>
namespace cg = cooperative_groups;

#define DI __device__ __forceinline__
#define LAS __attribute__((address_space(3)))
typedef unsigned short bf16_t;
typedef short bf16x8 __attribute__((ext_vector_type(8)));
typedef float f32x2 __attribute__((ext_vector_type(2)));
typedef float f32x4 __attribute__((ext_vector_type(4)));
typedef float f32x16 __attribute__((ext_vector_type(16)));
typedef unsigned u32x2 __attribute__((ext_vector_type(2)));
typedef unsigned u32x4 __attribute__((ext_vector_type(4)));
typedef __bf16 bf16v2 __attribute__((ext_vector_type(2)));

constexpr int NB = 2, S = 16384, T = NB * S, D = 2048, CONVW = 1024, INW = 5656, INWP = 5888, DFF = 5632;
constexpr float EPS = 1e-6f;
constexpr size_t MiB = 1u << 20;
constexpr size_t WS_ADA = 0, WS_ROPE = 1 * MiB, WS_WIN = 17 * MiB, WS_WOUT = 40 * MiB, WS_W13 = 48 * MiB, WS_W2 = 92 * MiB,
                 WS_CW1K = 114 * MiB, WS_CW1V = 116 * MiB, WS_CB1 = 118 * MiB, WS_HID = 119 * MiB, WS_KCMP = 127 * MiB, WS_VCMPT = 128 * MiB,
                 WS_GL = 129 * MiB, WS_KV6 = 132 * MiB, WS_KSL = 230 * MiB, WS_KWN = 246 * MiB, WS_VSLT = 262 * MiB, WS_VWNT = 278 * MiB,
                 WS_QR = 294 * MiB, WS_CONVIN = 358 * MiB, WS_XN = 614 * MiB, WS_Y = 742 * MiB, WS_ACT = 230 * MiB, WS_QR8 = 870 * MiB, WS_KSL32 = 902 * MiB, WS_VSL32 = 918 * MiB, WS_X1B = 870 * MiB  , WS_END = 998 * MiB;
constexpr size_t WS_SUMSQ = WS_CB1 + 65536, WS_BIAS13 = WS_CB1 + 262144;
constexpr size_t WS_BAR = WS_CB1 + 524288;
constexpr int LDS_BYTES = 8 * 18048 + 64;
constexpr int WAVE_LDS = 18048;

DI unsigned pk2(float lo, float hi) { f32x2 v = {lo, hi}; bf16v2 b = __builtin_convertvector(v, bf16v2); return __builtin_bit_cast(unsigned, b); }
DI float bf2f(bf16_t v) { return __uint_as_float((unsigned)v << 16); }
DI float wsum64(float v) {
#pragma unroll
    for (int o = 1; o < 64; o <<= 1) v += __shfl_xor(v, o);
    return v;
}
DI float sigmoidf_(float x) { return __builtin_amdgcn_rcpf(1.f + __expf(-x)); }
#define LDS_WAIT() asm volatile("s_waitcnt lgkmcnt(0)" ::: "memory")
DI int opaque(int x) { asm volatile("" : "+v"(x)); return x; }

namespace pg8 {
constexpr int BM = 256, BK = 64, HALF = 128, HTB = HALF * BK * 2, STAGE_BYTES = 8 * HTB, NXCD = 8;
__host__ __device__ __forceinline__ int lds_byte(int r, int c) { const int st = (r >> 4) * 2 + (c >> 5), rr = r & 15, cc = c & 31, ob = rr * 64 + cc * 2; return st * 1024 + (ob ^ (((ob >> 9) & 1) << 5)); }
__host__ __device__ __forceinline__ void stage_rc(int b, int& R, int& C) { const int st = b / 1024, sb = b % 1024, swz = sb ^ (((sb >> 9) & 1) << 5); R = (st >> 1) * 16 + swz / 64; C = (st & 1) * 32 + (swz % 64) / 2; }
__host__ __device__ __forceinline__ int perm32(int rho) { const int n = rho >> 4, i = rho & 15; return 8 * (i >> 2) + 4 * n + (i & 3); }
struct Unit { int pm, pn; };
struct Gemm { const bf16_t* A; const bf16_t* Bt; int M, N, K, lda; };
struct StaticOrder {
    int nM, nN, nwg, G, c, WGM;
    __device__ void init(int M, int N, int G_, int c_, int wgm) { nM = M / BM; nN = N / BM; nwg = nM * nN; G = G_; c = c_; WGM = wgm; }
    __device__ bool next(int i, Unit& u) const {
        const long L = (long)i * G + c; if (L >= nwg) return false;
        int wgid = (int)L; { const int q = nwg / NXCD, r = nwg % NXCD, xcd = wgid % NXCD, off = wgid / NXCD; wgid = (xcd < r ? xcd * (q + 1) : r * (q + 1) + (xcd - r) * q) + off; }
        const int nig = WGM * nN, gid = wgid / nig, fm = gid * WGM, gsz = (nM - fm) < WGM ? (nM - fm) : WGM;
        u.pm = fm + ((wgid % nig) % gsz); u.pn = (wgid % nig) / gsz; return true;
    }
};
struct OneUnit { int pm; __device__ bool next(int i, Unit& u) const { if (i) return false; u.pm = pm; u.pn = 0; return true; } };

template <class Epi, class Sched, bool ALIGN_EPI>
DI void gemm_phase(LAS unsigned char* lds, const Gemm g, const Sched& S_, const Epi& E) {
    const int tid = opaque((int)threadIdx.x), wid = __builtin_amdgcn_readfirstlane(tid >> 6), lane = tid & 63, wr = wid >> 2, wc = wid & 3, fr = lane & 15, fq = lane >> 4;
    const int K = g.K, nt = K / BK, lda = g.lda;
    unsigned voffA[2], voffB[2];
#pragma unroll
    for (int i = 0; i < 2; ++i) { int R, C; stage_rc(tid * 16 + i * 8192, R, C); const int Rb = Epi::PERM ? ((R & ~31) + perm32(R & 31)) : R;
        voffA[i] = (unsigned)(R * lda + C) * 2u; voffB[i] = (unsigned)(Rb * K + C) * 2u; }
    const size_t kstep = (size_t)(BK * 2);
    const size_t hstepA = (size_t)HALF * lda * 2, hstepB = (size_t)HALF * K * 2;
    const size_t tstepA = 2 * hstepA, tstepB = 2 * hstepB;
    const unsigned ldsw = (unsigned)wid * 1024u;
    const int aoff = lds_byte(wr * 64 + fr, fq * 8), boff = lds_byte(wc * 32 + fr, fq * 8);
#define PG8_SA(b, h) (((b) * 2 + (h)) * HTB)
#define PG8_SB(b, h) ((4 + (b) * 2 + (h)) * HTB)
#define PG8_STAGE(bufoff, gbase, voff) do { _Pragma("unroll") for (int _i = 0; _i < 2; ++_i) \
        __builtin_amdgcn_global_load_lds((const unsigned*)((const char*)(gbase) + (voff)[_i]), (LAS unsigned*)(lds + (bufoff) + ldsw + _i * 8192), 16, 0, 0); } while (0)
#define PG8_LDA(dst, b, h) do { _Pragma("unroll") for (int m = 0; m < 4; ++m) _Pragma("unroll") for (int k = 0; k < 2; ++k) dst[m][k] = *(const LAS bf16x8*)(lds + PG8_SA(b, h) + aoff + m * 2048 + k * 1024); } while (0)
#define PG8_LDB(dst, b, h) do { _Pragma("unroll") for (int n = 0; n < 2; ++n) _Pragma("unroll") for (int k = 0; k < 2; ++k) dst[n][k] = *(const LAS bf16x8*)(lds + PG8_SB(b, h) + boff + n * 2048 + k * 1024); } while (0)
#define PG8_MMA(ai, bj, At, Bt) do { __builtin_amdgcn_s_setprio(1); _Pragma("unroll") for (int m = 0; m < 4; ++m) _Pragma("unroll") for (int n = 0; n < 2; ++n) _Pragma("unroll") for (int k = 0; k < 2; ++k) \
        acc[ai][bj][m][n] = __builtin_amdgcn_mfma_f32_16x16x32_bf16(Bt[n][k], At[m][k], acc[ai][bj][m][n], 0, 0, 0); __builtin_amdgcn_s_setprio(0); } while (0)
#define PG8_WAIT_V(n) asm volatile("s_waitcnt vmcnt(" #n ")" ::: "memory")
#define PG8_WAIT_L(n) asm volatile("s_waitcnt lgkmcnt(" #n ")" ::: "memory")
#define PG8_BAR __builtin_amdgcn_s_barrier()
#define PG8_SCHED __builtin_amdgcn_sched_barrier(0)
    Unit cur, nxt; int ui = 0;
    if (!S_.next(0, cur)) return;
    f32x4 acc[2][2][4][2];
#pragma unroll
    for (int a = 0; a < 2; ++a)
#pragma unroll
        for (int b = 0; b < 2; ++b)
#pragma unroll
            for (int m = 0; m < 4; ++m)
#pragma unroll
                for (int n = 0; n < 2; ++n) acc[a][b][m][n] = (f32x4){0.f, 0.f, 0.f, 0.f};
    bf16x8 At[4][2], B0[2][2], B1[2][2];
    const char* cA = (const char*)g.A + (size_t)cur.pm * tstepA; const char* cB = (const char*)g.Bt + (size_t)cur.pn * tstepB;
    PG8_STAGE(PG8_SB(0, 0), cB, voffB); PG8_STAGE(PG8_SB(0, 1), cB + hstepB, voffB); PG8_STAGE(PG8_SA(0, 0), cA, voffA); PG8_STAGE(PG8_SA(0, 1), cA + hstepA, voffA);
    if (wr == 1) PG8_BAR;
    PG8_WAIT_V(2); PG8_BAR;
    PG8_STAGE(PG8_SB(1, 0), cB + kstep, voffB); PG8_STAGE(PG8_SA(1, 0), cA + kstep, voffA); PG8_STAGE(PG8_SB(1, 1), cB + hstepB + kstep, voffB);
    PG8_WAIT_V(6); PG8_BAR;
    for (;;) {
        const bool has_next = S_.next(ui + 1, nxt);
        const char* nA = has_next ? (const char*)g.A + (size_t)nxt.pm * tstepA : cA; const char* nB = has_next ? (const char*)g.Bt + (size_t)nxt.pn * tstepB : cB;
        for (int t = 0; t < nt; t += 2) {
            const bool last = (t == nt - 2);
            const char* a1 = cA + (size_t)(t + 1) * kstep;
            const char* a2 = last ? nA : cA + (size_t)(t + 2) * kstep; const char* b2 = last ? nB : cB + (size_t)(t + 2) * kstep;
            const char* a3 = a2 + kstep; const char* b3 = b2 + kstep;
            PG8_LDB(B0, 0, 0); PG8_LDB(B1, 0, 1); PG8_SCHED; PG8_LDA(At, 0, 0); PG8_STAGE(PG8_SA(1, 1), a1 + hstepA, voffA);
            PG8_WAIT_V(8); PG8_WAIT_L(0); PG8_BAR; PG8_MMA(0, 0, At, B0); PG8_MMA(0, 1, At, B1); PG8_BAR; PG8_SCHED;
            PG8_LDA(At, 0, 1); PG8_STAGE(PG8_SB(0, 0), b2, voffB); PG8_STAGE(PG8_SB(0, 1), b2 + hstepB, voffB); PG8_STAGE(PG8_SA(0, 0), a2, voffA);
            PG8_WAIT_V(8); PG8_WAIT_L(0); PG8_BAR; PG8_MMA(1, 0, At, B0); PG8_MMA(1, 1, At, B1); PG8_BAR; PG8_SCHED;
            PG8_LDB(B0, 1, 0); PG8_LDB(B1, 1, 1); PG8_SCHED; PG8_LDA(At, 1, 0); PG8_STAGE(PG8_SA(0, 1), a2 + hstepA, voffA);
            PG8_WAIT_V(8); PG8_WAIT_L(0); PG8_BAR; PG8_MMA(0, 0, At, B0); PG8_MMA(0, 1, At, B1); PG8_BAR; PG8_SCHED;
            PG8_LDA(At, 1, 1); PG8_STAGE(PG8_SB(1, 0), b3, voffB); PG8_STAGE(PG8_SB(1, 1), b3 + hstepB, voffB); PG8_STAGE(PG8_SA(1, 0), a3, voffA);
            PG8_WAIT_V(8); PG8_WAIT_L(0); PG8_BAR; PG8_MMA(1, 0, At, B0); PG8_MMA(1, 1, At, B1); PG8_BAR; PG8_SCHED;
        }
        if constexpr (ALIGN_EPI) { if (wr == 0) PG8_BAR; }
        E(acc, cur, wr, wc, fr, fq);
        if (!has_next) break;
#pragma unroll
        for (int a = 0; a < 2; ++a)
#pragma unroll
            for (int b = 0; b < 2; ++b)
#pragma unroll
                for (int m = 0; m < 4; ++m)
#pragma unroll
                    for (int n = 0; n < 2; ++n) acc[a][b][m][n] = (f32x4){0.f, 0.f, 0.f, 0.f};
        cur = nxt; cA = nA; cB = nB; ++ui;
        if constexpr (ALIGN_EPI) { if (wr == 1) PG8_BAR; }
    }
    PG8_WAIT_V(0);
    if constexpr (!ALIGN_EPI) { if (wr == 0) PG8_BAR; }
    PG8_BAR;
#undef PG8_SA
#undef PG8_SB
#undef PG8_STAGE
#undef PG8_LDA
#undef PG8_LDB
#undef PG8_MMA
#undef PG8_WAIT_V
#undef PG8_WAIT_L
#undef PG8_BAR
#undef PG8_SCHED
}

struct EpiProj {
    static constexpr bool PERM = true;
    bf16_t* convin; bf16_t* kv6; float* gl;
    DI void operator()(const f32x4 (&acc)[2][2][4][2], const Unit& u, int wr, int wc, int fr, int fq) const {
        const int row0 = u.pm * BM + wr * 64 + fr;
#pragma unroll
        for (int ai = 0; ai < 2; ++ai)
#pragma unroll
            for (int m = 0; m < 4; ++m) {
                const int row = row0 + ai * HALF + m * 16;
#pragma unroll
                for (int bj = 0; bj < 2; ++bj) {
                    const f32x4 v0 = acc[ai][bj][m][0], v1 = acc[ai][bj][m][1];
                    u32x4 w; w.x = pk2(v0[0], v0[1]); w.y = pk2(v0[2], v0[3]); w.z = pk2(v1[0], v1[1]); w.w = pk2(v1[2], v1[3]);
                    if (u.pn < 16) {
                        *(u32x4*)(convin + (size_t)row * 4096 + u.pn * 256 + bj * HALF + wc * 32 + 8 * fq) = w;
                    } else if (u.pn < 22) {
                        const int ti = u.pn - 16, b = row >> 14, s = row & (S - 1);
                        *(u32x4*)(kv6 + ((size_t)((ti * 4 + b * 2 + bj)) * S + s) * 128 + wc * 32 + 8 * fq) = w;
                    } else if (bj == 0 && wc == 0 && fq < 3) {
                        *(f32x4*)(gl + (size_t)row * 24 + 8 * fq) = v0; *(f32x4*)(gl + (size_t)row * 24 + 8 * fq + 4) = v1;
                    }
                }
            }
    }
};
struct EpiHid {
    static constexpr bool PERM = true;
    float* hid; const float* bias;
    DI void operator()(const f32x4 (&acc)[2][2][4][2], const Unit& u, int wr, int wc, int fr, int fq) const {
        const int row0 = u.pm * BM + wr * 64 + fr;
#pragma unroll
        for (int bj = 0; bj < 2; ++bj) {
            const int col = bj * HALF + wc * 32 + 8 * fq;
            const f32x4 b0 = *(const f32x4*)(bias + col), b1 = *(const f32x4*)(bias + col + 4);
#pragma unroll
            for (int ai = 0; ai < 2; ++ai)
#pragma unroll
                for (int m = 0; m < 4; ++m) {
                    const int row = row0 + ai * HALF + m * 16;
                    f32x4 v0 = acc[ai][bj][m][0] + b0, v1 = acc[ai][bj][m][1] + b1;
#pragma unroll
                    for (int e = 0; e < 4; ++e) {
                        float x = v0[e]; float z = 0.7978845608f * (x + 0.044715f * x * x * x); v0[e] = x * __builtin_amdgcn_rcpf(1.f + __expf(-2.f * z));
                        x = v1[e]; z = 0.7978845608f * (x + 0.044715f * x * x * x); v1[e] = x * __builtin_amdgcn_rcpf(1.f + __expf(-2.f * z));
                    }
                    *(f32x4*)(hid + (size_t)row * 256 + col) = v0; *(f32x4*)(hid + (size_t)row * 256 + col + 4) = v1;
                }
        }
    }
};
struct EpiRes {
    static constexpr bool PERM = true;
    const bf16_t* base; float* out; const float* gate;
    DI void operator()(const f32x4 (&acc)[2][2][4][2], const Unit& u, int wr, int wc, int fr, int fq) const {
        const int row0 = u.pm * BM + wr * 64 + fr, col0 = u.pn * BM + wc * 32 + 8 * fq;
        const int b = (u.pm * BM) >> 14;
#pragma unroll
        for (int bj = 0; bj < 2; ++bj) {
            const int col = col0 + bj * HALF;
            const f32x4 g0 = *(const f32x4*)(gate + (size_t)b * 12288 + col), g1 = *(const f32x4*)(gate + (size_t)b * 12288 + col + 4);
#pragma unroll
            for (int ai = 0; ai < 2; ++ai)
#pragma unroll
                for (int m = 0; m < 4; ++m) {
                    const size_t off = (size_t)(row0 + ai * HALF + m * 16) * D + col;
                    const u32x4 bw = *(const u32x4*)(base + off);
                    const f32x4 b0 = {__uint_as_float(bw.x << 16), __uint_as_float(bw.x & 0xffff0000u), __uint_as_float(bw.y << 16), __uint_as_float(bw.y & 0xffff0000u)};
                    const f32x4 b1 = {__uint_as_float(bw.z << 16), __uint_as_float(bw.z & 0xffff0000u), __uint_as_float(bw.w << 16), __uint_as_float(bw.w & 0xffff0000u)};
                    *(f32x4*)(out + off) = b0 + g0 * acc[ai][bj][m][0]; *(f32x4*)(out + off + 4) = b1 + g1 * acc[ai][bj][m][1];
                }
        }
    }
};
struct EpiRes2 {
    static constexpr bool PERM = true;
    const float* base; bf16_t* out; const float* gate; const float* gain; const float* scl; bf16_t* xs; float* sumsq;
    DI void operator()(const f32x4 (&acc)[2][2][4][2], const Unit& u, int wr, int wc, int fr, int fq) const {
        const int row0 = u.pm * BM + wr * 64 + fr, col0 = u.pn * BM + wc * 32 + 8 * fq;
        const int b = (u.pm * BM) >> 14;
        float ss[2][4];
#pragma unroll
        for (int ai = 0; ai < 2; ++ai)
#pragma unroll
            for (int m = 0; m < 4; ++m) ss[ai][m] = 0.f;
#pragma unroll
        for (int bj = 0; bj < 2; ++bj) {
            const int col = col0 + bj * HALF;
            const f32x4 gv0 = *(const f32x4*)(gate + (size_t)b * 12288 + col), gv1 = *(const f32x4*)(gate + (size_t)b * 12288 + col + 4);
            const f32x4 gm0 = *(const f32x4*)(gain + col) * (*(const f32x4*)(scl + (size_t)b * 12288 + col) + 1.f), gm1 = *(const f32x4*)(gain + col + 4) * (*(const f32x4*)(scl + (size_t)b * 12288 + col + 4) + 1.f);
#pragma unroll
            for (int ai = 0; ai < 2; ++ai)
#pragma unroll
                for (int m = 0; m < 4; ++m) {
                    const size_t off = (size_t)(row0 + ai * HALF + m * 16) * D + col;
                    const f32x4 xa = *(const f32x4*)(base + off) + gv0 * acc[ai][bj][m][0], xb = *(const f32x4*)(base + off + 4) + gv1 * acc[ai][bj][m][1];
                    { u32x4 w1; w1.x = pk2(xa.x, xa.y); w1.y = pk2(xa.z, xa.w); w1.z = pk2(xb.x, xb.y); w1.w = pk2(xb.z, xb.w); *(u32x4*)(out + off) = w1; }
                    ss[ai][m] += ((xa.x * xa.x + xa.y * xa.y) + (xa.z * xa.z + xa.w * xa.w)) + ((xb.x * xb.x + xb.y * xb.y) + (xb.z * xb.z + xb.w * xb.w));
                    const f32x4 ma = xa * gm0, mb = xb * gm1; u32x4 w; w.x = pk2(ma.x, ma.y); w.y = pk2(ma.z, ma.w); w.z = pk2(mb.x, mb.y); w.w = pk2(mb.z, mb.w);
                    *(u32x4*)(xs + off) = w;
                }
        }
#pragma unroll
        for (int ai = 0; ai < 2; ++ai)
#pragma unroll
            for (int m = 0; m < 4; ++m) { float v = ss[ai][m]; v += __shfl_xor(v, 16); v += __shfl_xor(v, 32);
                if (fq == 0) atomicAdd(sumsq + row0 + ai * HALF + m * 16, v); }
    }
};
struct EpiSwiGLU {
    static constexpr bool PERM = true;
    bf16_t* act; const float* sumsq; const float* bias;
    DI void operator()(const f32x4 (&acc)[2][2][4][2], const Unit& u, int wr, int wc, int fr, int fq) const {
        const int row0 = u.pm * BM + wr * 64 + fr, col = u.pn * HALF + wc * 32 + 8 * fq;
        const int b = (u.pm * BM) >> 14;
        const float* bp = bias + (size_t)b * (2 * DFF) + u.pn * BM + wc * 32 + 8 * fq;
        const f32x4 ba0 = *(const f32x4*)bp, ba1 = *(const f32x4*)(bp + 4), bb0 = *(const f32x4*)(bp + HALF), bb1 = *(const f32x4*)(bp + HALF + 4);
#pragma unroll
        for (int ai = 0; ai < 2; ++ai)
#pragma unroll
            for (int m = 0; m < 4; ++m) {
                const int row = row0 + ai * HALF + m * 16;
                const float rstd = rsqrtf(sumsq[row] * (1.f / D) + EPS);
                float o[8];
#pragma unroll
                for (int n = 0; n < 2; ++n)
#pragma unroll
                    for (int e = 0; e < 4; ++e) { const float a = acc[ai][0][m][n][e] * rstd + (n ? ba1[e] : ba0[e]), bv = acc[ai][1][m][n][e] * rstd + (n ? bb1[e] : bb0[e]);
                        o[4 * n + e] = a * __builtin_amdgcn_rcpf(1.f + __expf(-a)) * bv; }
                u32x4 w; w.x = pk2(o[0], o[1]); w.y = pk2(o[2], o[3]); w.z = pk2(o[4], o[5]); w.w = pk2(o[6], o[7]);
                *(u32x4*)(act + (size_t)row * DFF + col) = w;
            }
    }
};
}

#define XB_TMO      128
#define XB_XCNT(j)  (256  + 64 * (j))
#define XB_XSUB(j)  (1280 + 64 * (j))
#define XB_XGEN(j)  (2304 + 64 * (j))
#define XB_TOP      3328
#define XB_TOPGEN   3392
#define XCD_BAR_WORDS 3456
#define XB_SPIN_CAP (1u << 18)

__device__ __forceinline__ unsigned xb_ld(unsigned* p)              { return __hip_atomic_load(p, __ATOMIC_RELAXED, __HIP_MEMORY_SCOPE_AGENT); }
__device__ __forceinline__ unsigned xb_add(unsigned* p, unsigned v) { return __hip_atomic_fetch_add(p, v, __ATOMIC_RELAXED, __HIP_MEMORY_SCOPE_AGENT); }
__device__ __forceinline__ unsigned xb_xcc_id() { return (unsigned)__builtin_amdgcn_s_getreg((3 << 11) | 20) & 0xFu; }
#define XB_SPIN(cond, bar) do { unsigned _sp = 0; while (cond) { __builtin_amdgcn_s_sleep(1); \
    if ((++_sp & 255u) == 0u) { if (xb_ld(&(bar)[XB_TMO])) break; if (_sp > XB_SPIN_CAP) { atomicAdd(&(bar)[XB_TMO], 1u); break; } } } } while (0)

struct XcdBarrier {
    unsigned* bar; unsigned x;
    volatile LAS unsigned* st;
};

__device__ __forceinline__ XcdBarrier xcd_barrier_post(unsigned* bar, volatile LAS unsigned* st) {
    XcdBarrier b; b.bar = bar; b.x = xb_xcc_id(); b.st = st;
    if (threadIdx.x == 0) (void)xb_add(&bar[XB_XCNT(b.x)], 1u);
    return b;
}
__device__ __forceinline__ void xcd_barrier_complete(unsigned* bar, unsigned x, unsigned& nloc, unsigned& nx) {
    const unsigned G = gridDim.x * gridDim.y * gridDim.z;
    unsigned sum, cnt, mine, sp = 0u;
    for (;;) {
        sum = 0u; cnt = 0u; mine = 0u;
#pragma unroll
        for (unsigned j = 0; j < 16; ++j) { const unsigned c = xb_ld(&bar[XB_XCNT(j)]); sum += c; cnt += (c > 0u) ? 1u : 0u; mine = (j == x) ? c : mine; }
        if (sum == G) break;
        __builtin_amdgcn_s_sleep(1);
        if ((++sp & 255u) == 0u) { if (xb_ld(&bar[XB_TMO])) break; if (sp > XB_SPIN_CAP) { atomicAdd(&bar[XB_TMO], 1u); break; } }
    }
    nloc = mine > 0u ? mine : 1u; nx = cnt > 0u ? cnt : 1u;
}

__device__ __forceinline__ void xcd_barrier(const XcdBarrier& b) {
    asm volatile("s_waitcnt vmcnt(0)" ::: "memory");
    __syncthreads();
    if (threadIdx.x == 0) {
        unsigned* bar = b.bar;
        __builtin_amdgcn_s_waitcnt(0);
        unsigned nloc = b.st[0], nx = b.st[1];
        if (nloc == 0u) { xcd_barrier_complete(bar, b.x, nloc, nx); b.st[0] = nloc; b.st[1] = nx; }
        const unsigned old = xb_add(&bar[XB_XSUB(b.x)], 1u);
        const unsigned gen = old / nloc;
        if (old + 1u == (gen + 1u) * nloc) {
            __builtin_amdgcn_fence(__ATOMIC_RELEASE, "agent");
            asm volatile("s_waitcnt vmcnt(0)" ::: "memory");
            const unsigned og = xb_add(&bar[XB_TOP], 1u);
            const unsigned tg = og / nx;
            if (og + 1u == (tg + 1u) * nx) xb_add(&bar[XB_TOPGEN], 1u);
            else XB_SPIN(xb_ld(&bar[XB_TOPGEN]) == tg, bar);
            __builtin_amdgcn_fence(__ATOMIC_ACQUIRE, "agent");
            xb_add(&bar[XB_XGEN(b.x)], 1u);
            asm volatile("s_waitcnt vmcnt(0)" ::: "memory");
        } else {
            XB_SPIN(xb_ld(&bar[XB_XGEN(b.x)]) == gen, bar);
            __builtin_amdgcn_fence(__ATOMIC_ACQUIRE, "agent");
            asm volatile("s_waitcnt vmcnt(0)" ::: "memory");
        }
    }
    __syncthreads();
}


struct Args { const float* in[25]; float* out; unsigned char* ws; };
enum { I_X = 0, I_C, I_POS, I_ADAW, I_ADAB, I_NMIX, I_NFFN, I_WIN, I_CONVW, I_PEK, I_KW1, I_KB1, I_KW2, I_PEV, I_VW1, I_VB1, I_VW2, I_QN, I_KN, I_ONC, I_ONA, I_WOUT, I_W1, I_W3, I_W2 };

DI void transpose_item(const float* W, int K, int N, bf16_t* WT, int mode, LAS float* scr, int item, int lane, const float* kscA = nullptr, const float* kscB = nullptr) {
    const int nblk = (N + 63) / 64, kb = item / nblk, nb = item % nblk, k0 = 64 * kb, n0 = 64 * nb;
    const int nn = n0 + lane; const bool okc = nn < N;
    const float* wp = W + (size_t)k0 * N + (okc ? nn : 0);
#pragma unroll 16
    for (int i = 0; i < 64; ++i) { const int kg = k0 + i; float v = wp[(size_t)i * N]; if (kscA) v *= (kg < 1024 ? kscA[kg] : kscB[kg - 1024]); scr[i * 65 + lane] = okc ? v : 0.f; }
    LDS_WAIT();
    const int c = lane & 7;
#pragma unroll
    for (int j = 0; j < 8; ++j) { const int n = (lane >> 3) + 8 * j; const LAS float* sp = scr + (8 * c) * 65 + n;
        u32x4 o; o.x = pk2(sp[0 * 65], sp[1 * 65]); o.y = pk2(sp[2 * 65], sp[3 * 65]); o.z = pk2(sp[4 * 65], sp[5 * 65]); o.w = pk2(sp[6 * 65], sp[7 * 65]);
        const int ng = n0 + n;
        if (ng < N) { const int row = mode == 0 ? ng : (256 * (ng >> 7) + (ng & 127) + (mode == 2 ? 128 : 0)); *(u32x4*)(WT + (size_t)row * K + k0 + 8 * c) = o; } }
    LDS_WAIT();
}

DI void p0_prologue(const Args& a, LAS unsigned char* lds, int tid, int lane, int wave, int G) {
    unsigned char* ws = a.ws;
    const int gw = blockIdx.x * 8 + wave, NGW = G * 8;
    float* ADA = (float*)(ws + WS_ADA); float* CB1 = (float*)(ws + WS_CB1);
    LAS float* red = (LAS float*)lds;
    for (int task = blockIdx.x; task < 100; task += G) {
        const float *W, *v0, *v1, *bias; float *o0, *o1; int K, N, col0; bool dosilu;
        if (task < 96) { W = a.in[I_ADAW]; K = 2048; N = 12288; col0 = task * 128; v0 = a.in[I_C]; v1 = a.in[I_C] + 2048; dosilu = true; bias = a.in[I_ADAB] + col0; o0 = ADA + col0; o1 = ADA + 12288 + col0; }
        else { const int kv = (task - 96) >> 1, cgp = (task - 96) & 1; W = a.in[kv ? I_VW1 : I_KW1]; K = 4096; N = 256; col0 = cgp * 128; v0 = a.in[kv ? I_PEV : I_PEK]; v1 = nullptr; dosilu = false;
            bias = a.in[kv ? I_VB1 : I_KB1] + col0; o0 = CB1 + kv * 256 + col0; o1 = nullptr; }
        LAS float* vec = (LAS float*)(lds + 8192);
        for (int i = tid; i < K; i += 512) { float c0 = v0[i]; if (dosilu) c0 = c0 * __builtin_amdgcn_rcpf(1.f + __expf(-c0)); vec[i] = c0;
            float c1 = 0.f; if (v1) { c1 = v1[i]; c1 = c1 * __builtin_amdgcn_rcpf(1.f + __expf(-c1)); } vec[4096 + i] = c1; }
        __syncthreads();
        const int kper = K / 8; f32x2 a0 = {0.f, 0.f}, a1 = {0.f, 0.f};
        const float* wp = W + (size_t)(wave * kper) * N + col0 + 2 * lane;
        const LAS float* vp = vec + wave * kper;
#pragma unroll 16
        for (int k = 0; k < kper; ++k) { const f32x2 w = *(const f32x2*)(wp + (size_t)k * N); a0 += w * vp[k]; a1 += w * vp[4096 + k]; }
        *(LAS f32x2*)(red + (wave * 2 + 0) * 128 + 2 * lane) = a0; *(LAS f32x2*)(red + (wave * 2 + 1) * 128 + 2 * lane) = a1;
        __syncthreads();
        if (wave < 2) { float s0 = 0.f, s1 = 0.f;
#pragma unroll
            for (int w = 0; w < 8; ++w) { s0 += red[(w * 2 + wave) * 128 + lane]; s1 += red[(w * 2 + wave) * 128 + 64 + lane]; }
            float* op = wave ? o1 : o0; if (op) { op[lane] = s0 + bias[lane]; op[64 + lane] = s1 + bias[64 + lane]; } }
        __syncthreads();
    }
    { float* RC = (float*)(ws + WS_ROPE); float* RS = RC + (size_t)T * 64; const int* pos = (const int*)a.in[I_POS];
      for (int idx = gw * 64 + lane; idx < T * 64; idx += NGW * 64) { const int t = idx >> 6, i = idx & 63;
          const float inv = 1.0f / exp2f((float)i * (13.287712379549449f / 64.f)); const float ang = (float)pos[t] * inv;
          const double rev = (double)ang * 0.15915494309189535; const float fr = (float)(rev - __builtin_rint(rev));
          RC[idx] = __builtin_amdgcn_cosf(fr); RS[idx] = __builtin_amdgcn_sinf(fr); } }
    { LAS float* scr = (LAS float*)(lds + wave * WAVE_LDS);
      bf16_t* WinT = (bf16_t*)(ws + WS_WIN); bf16_t* WoutT = (bf16_t*)(ws + WS_WOUT); bf16_t* W13T = (bf16_t*)(ws + WS_W13); bf16_t* W2T = (bf16_t*)(ws + WS_W2);
      bf16_t* CW1K = (bf16_t*)(ws + WS_CW1K); bf16_t* CW1V = (bf16_t*)(ws + WS_CW1V);
      constexpr int I_IN = 32 * 89, I_O = 32 * 32, I_F1 = 32 * 88, I_F2 = 88 * 32, I_C1 = 64 * 4;
      constexpr int NITEMS = I_IN + I_O + 2 * I_F1 + I_F2 + 2 * I_C1;
      unsigned* qctr = (unsigned*)(ws + WS_BAR) + 3520;
      for (;;) { int it = 0; if (lane == 0) it = (int)atomicAdd(qctr, 1u); it = __builtin_amdgcn_readfirstlane(it); if (it >= NITEMS) break; int r = it;
          if (r < I_IN) { transpose_item(a.in[I_WIN], D, INW, WinT, 0, scr, r, lane); continue; } r -= I_IN;
          if (r < I_O) { transpose_item(a.in[I_WOUT], D, D, WoutT, 0, scr, r, lane, a.in[I_ONC], a.in[I_ONA]); continue; } r -= I_O;
          if (r < I_F1) { transpose_item(a.in[I_W1], D, DFF, W13T, 1, scr, r, lane); continue; } r -= I_F1;
          if (r < I_F1) { transpose_item(a.in[I_W3], D, DFF, W13T, 2, scr, r, lane); continue; } r -= I_F1;
          if (r < I_F2) { transpose_item(a.in[I_W2], DFF, D, W2T, 0, scr, r, lane); continue; } r -= I_F2;
          if (r < I_C1) { transpose_item(a.in[I_KW1], 4096, 256, CW1K, 0, scr, r, lane); continue; } r -= I_C1;
          transpose_item(a.in[I_VW1], 4096, 256, CW1V, 0, scr, r, lane); }
      u32x4* z = (u32x4*)(WinT + (size_t)INW * D); const int nz = (INWP - INW) * D / 8;
      for (int i = blockIdx.x * 512 + tid; i < nz; i += G * 512) z[i] = (u32x4){0u, 0u, 0u, 0u}; }
}

DI void norm_mod_rows(const float* src, const float* gain, const float* ada, int shi, int sci, bf16_t* dst, int gw, int NGW, int lane) {
    f32x4 gm[8], sh[8]; int bprev = -1;
    for (int m = gw; m < T; m += NGW) {
        const int b = m >> 14;
        if (b != bprev) { bprev = b;
#pragma unroll
            for (int j = 0; j < 8; ++j) { const int col = 4 * lane + 256 * j;
                gm[j] = *(const f32x4*)(gain + col) * (*(const f32x4*)(ada + b * 12288 + sci * 2048 + col) + 1.f); sh[j] = *(const f32x4*)(ada + b * 12288 + shi * 2048 + col); } }
        const f32x4* xr = (const f32x4*)(src + (size_t)m * D) + lane;
        f32x4 v[8]; float s = 0.f;
#pragma unroll
        for (int j = 0; j < 8; ++j) { v[j] = xr[64 * j]; s += (v[j].x * v[j].x + v[j].y * v[j].y) + (v[j].z * v[j].z + v[j].w * v[j].w); }
        const float rstd = rsqrtf(wsum64(s) * (1.f / D) + EPS);
#pragma unroll
        for (int j = 0; j < 8; ++j) { const int col = 4 * lane + 256 * j;
            const f32x4 o = v[j] * rstd * gm[j] + sh[j];
            u32x2 w; w.x = pk2(o.x, o.y); w.y = pk2(o.z, o.w);
            *(u32x2*)(dst + (size_t)m * D + col) = w; }
    }
}

DI void bias13_rows(const bf16_t* W13T, const float* ada, float* bias13, int gw, int NGW, int lane) {
    for (int n = gw; n < 2 * DFF; n += NGW) {
        float s0 = 0.f, s1 = 0.f;
#pragma unroll
        for (int j = 0; j < 4; ++j) { const int k = 8 * (lane + 64 * j); const u32x4 w = *(const u32x4*)(W13T + (size_t)n * D + k);
#pragma unroll
            for (int e = 0; e < 4; ++e) { const float wa = __uint_as_float(w[e] << 16), wb = __uint_as_float(w[e] & 0xffff0000u);
                s0 += wa * ada[3 * 2048 + k + 2 * e] + wb * ada[3 * 2048 + k + 2 * e + 1];
                s1 += wa * ada[12288 + 3 * 2048 + k + 2 * e] + wb * ada[12288 + 3 * 2048 + k + 2 * e + 1]; } }
        s0 = wsum64(s0); s1 = wsum64(s1);
        if (lane == 0) { bias13[n] = s0; bias13[2 * DFF + n] = s1; }
    }
}

DI float dpp_x1(float v) { return __int_as_float(__builtin_amdgcn_update_dpp(0, __float_as_int(v), 0xB1, 0xF, 0xF, false)); }
DI float dpp_x2(float v) { return __int_as_float(__builtin_amdgcn_update_dpp(0, __float_as_int(v), 0x4E, 0xF, 0xF, false)); }
DI float dpp_r4(float v) { return __int_as_float(__builtin_amdgcn_update_dpp(0, __float_as_int(v), 0x124, 0xF, 0xF, false)); }
DI float dpp_r8(float v) { return __int_as_float(__builtin_amdgcn_update_dpp(0, __float_as_int(v), 0x128, 0xF, 0xF, false)); }
DI float row16_sum(float v) { v += dpp_x1(v); v += dpp_x2(v); v += dpp_r4(v); v += dpp_r8(v); return v; }
DI void conv_range(const Args& a, const bf16_t* CIN, bf16_t* Y, int tb, int te, int lane) {
    const float* cw = a.in[I_CONVW];
#pragma unroll 1
    for (int c2 = 0; c2 < 2; ++c2) {
        const int ch0 = 512 * c2 + 8 * lane;
        float w0[8], w1[8], w2[8], u1[8], u2[8];
#pragma unroll
        for (int e = 0; e < 8; ++e) { w0[e] = cw[ch0 + e]; w1[e] = cw[1024 + ch0 + e]; w2[e] = cw[2048 + ch0 + e]; u1[e] = 0.f; u2[e] = 0.f; }
#pragma unroll
        for (int back = 2; back >= 1; --back) {
            if ((tb & (S - 1)) >= back) {
                const bf16_t* rp = CIN + (size_t)(tb - back) * 4096;
                const u32x4 cc = *(const u32x4*)(rp + 1024 + ch0), hh = *(const u32x4*)(rp + 2048 + ch0);
#pragma unroll
                for (int e = 0; e < 4; ++e) { const float ca = __uint_as_float(cc[e] << 16), cb_ = __uint_as_float(cc[e] & 0xffff0000u), ha = __uint_as_float(hh[e] << 16), hb = __uint_as_float(hh[e] & 0xffff0000u);
                    if (back == 2) { u2[2 * e] = ca * ha; u2[2 * e + 1] = cb_ * hb; } else { u1[2 * e] = ca * ha; u1[2 * e + 1] = cb_ * hb; } }
            }
        }
#pragma unroll 4
        for (int t = tb; t < te; ++t) {
            if ((t & (S - 1)) == 0) {
#pragma unroll
                for (int e = 0; e < 8; ++e) { u1[e] = 0.f; u2[e] = 0.f; } }
            const bf16_t* rp = CIN + (size_t)t * 4096;
            const u32x4 bb = *(const u32x4*)(rp + ch0), cc = *(const u32x4*)(rp + 1024 + ch0), hh = *(const u32x4*)(rp + 2048 + ch0);
            float y[8]; float ss = 0.f;
#pragma unroll
            for (int e = 0; e < 4; ++e) {
                const float ca = __uint_as_float(cc[e] << 16), cb_ = __uint_as_float(cc[e] & 0xffff0000u), ha = __uint_as_float(hh[e] << 16), hb = __uint_as_float(hh[e] & 0xffff0000u);
                const float ba = __uint_as_float(bb[e] << 16), bbb = __uint_as_float(bb[e] & 0xffff0000u);
                const float ua = ca * ha, ub = cb_ * hb;
                y[2 * e] = ba * (w0[2 * e] * u2[2 * e] + w1[2 * e] * u1[2 * e] + w2[2 * e] * ua);
                y[2 * e + 1] = bbb * (w0[2 * e + 1] * u2[2 * e + 1] + w1[2 * e + 1] * u1[2 * e + 1] + w2[2 * e + 1] * ub);
                u2[2 * e] = u1[2 * e]; u2[2 * e + 1] = u1[2 * e + 1]; u1[2 * e] = ua; u1[2 * e + 1] = ub;
                ss += y[2 * e] * y[2 * e] + y[2 * e + 1] * y[2 * e + 1];
            }
            ss = row16_sum(ss);
            const float rstd = rsqrtf(ss * (1.f / 128.f) + EPS);
            u32x4 w; w.x = pk2(y[0] * rstd, y[1] * rstd); w.y = pk2(y[2] * rstd, y[3] * rstd);
            w.z = pk2(y[4] * rstd, y[5] * rstd); w.w = pk2(y[6] * rstd, y[7] * rstd);
            *(u32x4*)(Y + (size_t)t * D + ch0) = w;
        }
    }
}
DI int perm_slc(int p) { const int q = p & 31; return (p & 32) | (((q >> 2) & 1) << 4) | ((q >> 3) << 2) | (q & 3); }
DI int perm_w16(int p) { return (p & ~15) | (p & 3) | ((p & 4) << 1) | ((p & 8) >> 1); }
DI size_t k32_off(int n, int d) { return (size_t)(n >> 5) * 4096 + (d >> 4) * 512 + ((((d & 15) >> 3) * 32) + (n & 31)) * 8 + (d & 7); }
DI size_t k16_off(int s, int d) { return (size_t)(s >> 6) * 8192 + ((s >> 4) & 3) * 2048 + (d >> 5) * 512 + (s & 15) * 32 + (d & 31); }
DI unsigned fp8x2(float a, float b) { return (unsigned)__builtin_amdgcn_cvt_pk_fp8_f32(a, b, 0, false) & 0xffffu; }
DI bf16x8 fp8_frag(unsigned w0, unsigned w1) {
    u32x4 o;
    o.x = __builtin_bit_cast(unsigned, __builtin_amdgcn_cvt_scalef32_pk_bf16_fp8(w0, 1.0f, false)); o.y = __builtin_bit_cast(unsigned, __builtin_amdgcn_cvt_scalef32_pk_bf16_fp8(w0, 1.0f, true));
    o.z = __builtin_bit_cast(unsigned, __builtin_amdgcn_cvt_scalef32_pk_bf16_fp8(w1, 1.0f, false)); o.w = __builtin_bit_cast(unsigned, __builtin_amdgcn_cvt_scalef32_pk_bf16_fp8(w1, 1.0f, true));
    return __builtin_bit_cast(bf16x8, o);
}
DI size_t k8_off(int s_, int d) { return (size_t)(s_ >> 6) * 8192 + (((s_ >> 4) & 3) * 2 + (d >> 6)) * 1024 + ((((d & 31) >> 3) * 16) + (s_ & 15)) * 16 + ((d >> 5) & 1) * 8 + (d & 7); }
constexpr float QSCALE = 0.08838834764831845f * 1.4426950408889634f;
DI void normrope_item(const Args& a, unsigned char* ws, int tok, int lane) {
    const bf16_t* CIN = (const bf16_t*)(ws + WS_CONVIN); const bf16_t* KV6 = (const bf16_t*)(ws + WS_KV6);
    const int b = tok >> 14, s = tok & (S - 1), hsub = lane >> 4, l16 = lane & 15, d0 = 8 * l16;
    const float* RC = (const float*)(ws + WS_ROPE) + (size_t)tok * 64 + (d0 & 63); const float* RS = RC + (size_t)T * 64;
    const f32x4 c0 = *(const f32x4*)RC, c1 = *(const f32x4*)(RC + 4), s0 = *(const f32x4*)RS, s1 = *(const f32x4*)(RS + 4);
    const float cs[8] = {c0.x, c0.y, c0.z, c0.w, c1.x, c1.y, c1.z, c1.w};
    const float sgn = l16 < 8 ? -1.f : 1.f;
    const float sn[8] = {s0.x * sgn, s0.y * sgn, s0.z * sgn, s0.w * sgn, s1.x * sgn, s1.y * sgn, s1.z * sgn, s1.w * sgn};
#pragma unroll
    for (int p = 0; p < 3; ++p) {
        const bf16_t* src; const float* gain; float scale = 1.f; int kind;
        int head;
        if (p < 2) { head = 4 * p + hsub; kind = 0; src = CIN + (size_t)tok * 4096 + 3072 + head * 128 + d0; gain = a.in[I_QN]; scale = QSCALE; }
        else if (hsub < 2) { head = hsub; kind = 1; src = KV6 + ((size_t)(2 * 4 + b * 2 + head) * S + s) * 128 + d0; gain = a.in[I_KN] + 128; }
        else { head = hsub - 2; kind = 2; src = KV6 + ((size_t)(4 * 4 + b * 2 + head) * S + s) * 128 + d0; gain = a.in[I_KN] + 256; }
        const u32x4 raw = *(const u32x4*)src;
        const f32x4 g0 = *(const f32x4*)(gain + d0), g1 = *(const f32x4*)(gain + d0 + 4);
        const float gg[8] = {g0.x, g0.y, g0.z, g0.w, g1.x, g1.y, g1.z, g1.w};
        float x[8]; float ss = 0.f;
#pragma unroll
        for (int e = 0; e < 4; ++e) { x[2 * e] = __uint_as_float(raw[e] << 16); x[2 * e + 1] = __uint_as_float(raw[e] & 0xffff0000u); ss += x[2 * e] * x[2 * e] + x[2 * e + 1] * x[2 * e + 1]; }
        const float rstd = rsqrtf(row16_sum(ss) * (1.f / 128.f) + EPS);
        float o[8];
#pragma unroll
        for (int e = 0; e < 8; ++e) { const float y = x[e] * rstd * gg[e]; const float pr = dpp_r8(y); o[e] = (y * cs[e] + pr * sn[e]) * scale; }
        u32x4 wb; wb.x = pk2(o[0], o[1]); wb.y = pk2(o[2], o[3]); wb.z = pk2(o[4], o[5]); wb.w = pk2(o[6], o[7]);
        u32x2 w8; w8.x = fp8x2(o[0], o[1]) | (fp8x2(o[2], o[3]) << 16); w8.y = fp8x2(o[4], o[5]) | (fp8x2(o[6], o[7]) << 16);
        if (kind == 0) {
            *(u32x4*)((bf16_t*)(ws + WS_QR) + (size_t)tok * 1024 + head * 128 + d0) = wb;
            *(u32x2*)((unsigned char*)(ws + WS_QR8) + (size_t)tok * 1024 + head * 128 + d0) = w8;
        } else if (kind == 1) {
            *(u32x2*)((unsigned char*)(ws + WS_KSL) + (size_t)(b * 2 + head) * S * 128 + k8_off(s, d0)) = w8;
            *(u32x4*)((bf16_t*)(ws + WS_KSL32) + (size_t)(b * 2 + head) * S * 128 + k32_off(s, d0)) = wb;
        } else {
            *(u32x4*)((bf16_t*)(ws + WS_KWN) + (size_t)(b * 2 + head) * S * 128 + k32_off(s, d0)) = wb;
        }
    }
}
DI void vtrans_item(unsigned char* ws, int mode, int item, LAS unsigned char* scr, int lane) {
    const bf16_t* KV6 = (const bf16_t*)(ws + WS_KV6);
    const int bg = item >> 8, blk = item & 255;
    const bf16_t* src = KV6 + ((size_t)((mode == 1 ? 5 : 3) * 4 + bg) * S + 64 * blk) * 128;
#pragma unroll 4
    for (int i = 0; i < 16; ++i) { const int c = lane + 64 * i, key = c >> 4, dc = c & 15;
        *(LAS u32x4*)(scr + key * 272 + dc * 16) = *(const u32x4*)(src + (size_t)key * 128 + dc * 8); }
    LDS_WAIT();
    if (mode) {
        bf16_t* dstb = (bf16_t*)(ws + (mode == 1 ? WS_VWNT : WS_VSL32)) + ((size_t)bg * 256 + blk) * 8192;
#pragma unroll 4
        for (int i = 0; i < 16; ++i) { const int c = lane + 64 * i, d = c >> 3, pc = c & 7;
            unsigned w[4];
#pragma unroll
            for (int e = 0; e < 4; ++e) { const int p0 = 8 * pc + 2 * e, k0 = perm_w16(p0), k1 = perm_w16(p0 + 1);
                const unsigned lo = *(const LAS bf16_t*)(scr + k0 * 272 + d * 2), hi = *(const LAS bf16_t*)(scr + k1 * 272 + d * 2); w[e] = lo | (hi << 16); }
            const size_t off = (size_t)(pc >> 2) * 4096 + ((pc >> 1) & 1) * 2048 + (d >> 5) * 512 + ((pc & 1) * 32 + (d & 31)) * 8;
            *(u32x4*)(dstb + off) = (u32x4){w[0], w[1], w[2], w[3]}; }
    } else {
        unsigned char* dstb = (unsigned char*)(ws + WS_VSLT) + ((size_t)bg * 256 + blk) * 8192;
#pragma unroll 4
        for (int i = 0; i < 16; ++i) { const int c = lane + 64 * i, d = c >> 3, pc = c & 7;
            unsigned w[4];
#pragma unroll
            for (int e = 0; e < 4; ++e) { const int p0 = 8 * pc + 2 * e, k0 = perm_slc(p0), k1 = perm_slc(p0 + 1);
                const float lo = bf2f(*(const LAS bf16_t*)(scr + k0 * 272 + d * 2)), hi = bf2f(*(const LAS bf16_t*)(scr + k1 * 272 + d * 2)); w[e] = fp8x2(lo, hi); }
            const size_t off = (size_t)((pc >> 2) * 4 + (d >> 5)) * 1024 + ((pc & 3) * 16 + (d & 15)) * 16 + ((d >> 4) & 1) * 8;
            *(u32x2*)(dstb + off) = (u32x2){w[0] | (w[1] << 16), w[2] | (w[3] << 16)}; }
    }
    LDS_WAIT();
}

DI void cmp2_row(const Args& a, const unsigned char* ws, const LAS float* w2s, int kv, int m, int lane) {
    const int bg = m >> 10, n = m & 1023;
    bf16_t* KC = (bf16_t*)(ws + WS_KCMP) + (size_t)bg * 131072; bf16_t* VT = (bf16_t*)(ws + WS_VCMPT) + (size_t)bg * 131072;
    float o1 = 0.f, o2 = 0.f;
    if (n < 1023) {
        const float* hid = (const float*)(ws + WS_HID) + ((size_t)kv * 4096 + m) * 256;
        const f32x4 hv4 = *(const f32x4*)(hid + 4 * lane);
#pragma unroll 4
        for (int h4 = 0; h4 < 64; ++h4) {
#pragma unroll
            for (int e = 0; e < 4; ++e) { const float hv = __int_as_float(__builtin_amdgcn_readlane(__float_as_int(hv4[e]), h4));
                o1 += hv * w2s[(4 * h4 + e) * 128 + lane]; o2 += hv * w2s[(4 * h4 + e) * 128 + 64 + lane]; } }
    }
    if (kv == 0) {
        float ss = wsum64(o1 * o1 + o2 * o2); const float rstd = rsqrtf(ss * (1.f / 128.f) + EPS);
        const float* gain = a.in[I_KN]; o1 *= rstd * gain[lane]; o2 *= rstd * gain[64 + lane];
        const int b = bg >> 1, tok = b * S + ((n < 1023) ? 16 * n + 31 : 0);
        const float* RC = (const float*)(ws + WS_ROPE) + (size_t)tok * 64; const float* RS = RC + (size_t)T * 64;
        const float c = RC[lane], sn = RS[lane];
        const float r1 = o1 * c - o2 * sn, r2 = o2 * c + o1 * sn;
        KC[k32_off(n, lane)] = (bf16_t)(pk2(r1, 0.f) & 0xffffu); KC[k32_off(n, 64 + lane)] = (bf16_t)(pk2(r2, 0.f) & 0xffffu);
    } else {
        const int pp = perm_w16(n & 15);
        const size_t base = (size_t)(n >> 5) * 4096 + ((n >> 4) & 1) * 2048 + ((pp >> 3) * 32 + (lane & 31)) * 8 + (pp & 7);
        VT[base + (lane >> 5) * 512] = (bf16_t)(pk2(o1, 0.f) & 0xffffu);
        VT[base + (2 + (lane >> 5)) * 512] = (bf16_t)(pk2(o2, 0.f) & 0xffffu);
    }
}
DI void cmp2_phase(const Args& a, const unsigned char* ws, LAS unsigned char* lds, int tid, int wave, int G) {
    const int lane = tid & 63;
    for (int kv = 0; kv < 2; ++kv) {
        if (G > 1 && (int)(blockIdx.x & 1) != kv) continue;
        const int nb = G > 1 ? (G + 1 - kv) / 2 : 1, bi = G > 1 ? (int)(blockIdx.x >> 1) : 0;
        const float* w2 = a.in[kv ? I_VW2 : I_KW2];
        __syncthreads();
        for (int i = tid; i < 8192; i += 512) *(LAS f32x4*)(lds + i * 16) = *(const f32x4*)(w2 + 4 * i);
        __syncthreads();
        for (int m = bi * 8 + wave; m < 4096; m += nb * 8) cmp2_row(a, ws, (const LAS float*)lds, kv, m, lane);
    }
    __syncthreads();
}

#define MFMA32(a, b, c) __builtin_amdgcn_mfma_f32_32x32x16_bf16((a), (b), (c), 0, 0, 0)
#define MFMA16(a, b, c) __builtin_amdgcn_mfma_f32_16x16x32_bf16((a), (b), (c), 0, 0, 0)
#define MFMA16F8(a, b, c) __builtin_amdgcn_mfma_f32_16x16x32_fp8_fp8((a), (b), (c), 0, 0, 0)
DI long mk64(unsigned lo, unsigned hi) { return (long)(((unsigned long long)hi << 32) | lo); }
DI void ld8(bf16x8 (&k)[8], const bf16_t* p) {
#pragma unroll
    for (int i = 0; i < 8; ++i) k[i] = *(const bf16x8*)(p + i * 512);
}
DI f32x16 qk32(const bf16x8 (&k)[8], const bf16x8 (&q)[8]) {
    f32x16 s;
#pragma unroll
    for (int i = 0; i < 16; ++i) s[i] = 0.f;
    __builtin_amdgcn_s_setprio(1);
#pragma unroll
    for (int ks = 0; ks < 8; ++ks) s = MFMA32(k[ks], q[ks], s);
    __builtin_amdgcn_s_setprio(0);
    return s;
}
DI void pass1_tile(const bf16_t* Kb, int tile, int tnext, bf16x8 (&kc)[8], bf16x8 (&kn)[8], const bf16x8 (&q)[8], int limlo, int limhi, int lofs, int h, float& l) {
    ld8(kn, Kb + (size_t)tnext * 4096 + lofs);
    const int key0 = 32 * tile; const f32x16 s = qk32(kc, q);
#pragma unroll
    for (int i = 0; i < 16; ++i) { const int key = key0 + 8 * (i >> 2) + 4 * h + (i & 3); l += (key <= limhi && key > limlo) ? __builtin_amdgcn_exp2f(s[i]) : 0.f; }
}
DI float attn_pass1(const bf16_t* Kb, int tlo, int thi, const bf16x8 (&q)[8], int limlo, int limhi, int lofs, int h) {
    float l = 0.f; bf16x8 ka[8], kb[8]; ld8(ka, Kb + (size_t)tlo * 4096 + lofs);
    int tile = tlo;
#pragma unroll 1
    for (; tile < thi; tile += 2) {
        pass1_tile(Kb, tile, tile + 1, ka, kb, q, limlo, limhi, lofs, h, l);
        pass1_tile(Kb, tile + 1, tile + 2 <= thi ? tile + 2 : tile + 1, kb, ka, q, limlo, limhi, lofs, h, l);
    }
    if (tile == thi) pass1_tile(Kb, tile, tile, ka, kb, q, limlo, limhi, lofs, h, l);
    return l + __shfl_xor(l, 32);
}
template <bool IMP, bool PV, bool SB = false>
DI void pass2_tile(const bf16_t* Kb, const bf16_t* VTb, int tile, int tnext, bf16x8 (&kc)[8], bf16x8 (&kn)[8], const bf16x8 (&q)[8], int limlo, int limhi, float inv, float gate,
                   f32x16 (&O)[4], LAS float* imp, LAS float* car, int n, int h, int lofs, float& l) {
    bf16x8 vf[8]; if (PV) ld8(vf, VTb + (size_t)tile * 4096 + lofs);
    if (!SB) ld8(kn, Kb + (size_t)tnext * 4096 + lofs);
    const int key0 = 32 * tile; const f32x16 s = qk32(kc, q);
    if (SB) ld8(kc, Kb + (size_t)tnext * 4096 + lofs);
    const float pscale = IMP ? inv : inv * gate, pgate = IMP ? gate : 1.f;
    float p[16];
#pragma unroll
    for (int i = 0; i < 16; ++i) { const int key = key0 + 8 * (i >> 2) + 4 * h + (i & 3); p[i] = (key <= limhi && key > limlo) ? __builtin_amdgcn_exp2f(s[i]) * pscale : 0.f; l += p[i]; }
    if (PV) {
#pragma unroll
        for (int u = 0; u < 2; ++u) {
            u32x4 pw; pw.x = pk2(p[8 * u] * pgate, p[8 * u + 1] * pgate); pw.y = pk2(p[8 * u + 2] * pgate, p[8 * u + 3] * pgate);
            pw.z = pk2(p[8 * u + 4] * pgate, p[8 * u + 5] * pgate); pw.w = pk2(p[8 * u + 6] * pgate, p[8 * u + 7] * pgate);
            const bf16x8 pb = __builtin_bit_cast(bf16x8, pw);
            __builtin_amdgcn_s_setprio(1);
#pragma unroll
            for (int dt = 0; dt < 4; ++dt) O[dt] = MFMA32(vf[4 * u + dt], pb, O[dt]);
            __builtin_amdgcn_s_setprio(0);
        }
    }
    if (IMP) {
#pragma unroll
        for (int i4 = 0; i4 < 4; ++i4) {
            float P4 = (p[4 * i4] + p[4 * i4 + 1]) + (p[4 * i4 + 2] + p[4 * i4 + 3]), pl = p[4 * i4 + 3];
            P4 += dpp_x1(P4); P4 += dpp_x2(P4); pl += dpp_x1(pl); pl += dpp_x2(pl);
            if ((n & 3) == 0) { const int j = 8 * tile + 2 * i4 + h, ql = n >> 2; imp[ql * 256 + j] = P4; if (j + 1 < 256) car[ql * 256 + j + 1] = pl; }
        }
    }
}
template <bool IMP, bool PV, bool SB = false>
DI float attn_pass2(const bf16_t* Kb, const bf16_t* VTb, int tlo, int thi, const bf16x8 (&q)[8], int limlo, int limhi, float inv, float gate,
                   f32x16 (&O)[4], LAS float* imp, LAS float* car, int n, int h, int lofs) {
    float l = 0.f;
    if constexpr (SB) {
        bf16x8 kc[8]; ld8(kc, Kb + (size_t)tlo * 4096 + lofs);
#pragma unroll 1
        for (int tile = tlo; tile <= thi; ++tile) pass2_tile<IMP, PV, true>(Kb, VTb, tile, tile < thi ? tile + 1 : tile, kc, kc, q, limlo, limhi, inv, gate, O, imp, car, n, h, lofs, l);
        return l;
    }
    bf16x8 ka[8], kb[8]; ld8(ka, Kb + (size_t)tlo * 4096 + lofs);
    int tile = tlo;
#pragma unroll 1
    for (; tile < thi; tile += 2) {
        pass2_tile<IMP, PV>(Kb, VTb, tile, tile + 1, ka, kb, q, limlo, limhi, inv, gate, O, imp, car, n, h, lofs, l);
        pass2_tile<IMP, PV>(Kb, VTb, tile + 1, tile + 2 <= thi ? tile + 2 : tile + 1, kb, ka, q, limlo, limhi, inv, gate, O, imp, car, n, h, lofs, l);
    }
    if (tile == thi) pass2_tile<IMP, PV>(Kb, VTb, tile, tile, ka, kb, q, limlo, limhi, inv, gate, O, imp, car, n, h, lofs, l);
    return l;
}

DI void attn_item(const Args& a, const unsigned char* ws, LAS unsigned char* wl, int bg, int tile8, int lane) {
    const bf16_t* QR = (const bf16_t*)(ws + WS_QR); const float* GL = (const float*)(ws + WS_GL);
    const bf16_t* KC = (const bf16_t*)(ws + WS_KCMP) + (size_t)bg * 131072; const bf16_t* VCT = (const bf16_t*)(ws + WS_VCMPT) + (size_t)bg * 131072;
    const bf16_t* KW = (const bf16_t*)(ws + WS_KWN) + (size_t)bg * S * 128; const bf16_t* VWT = (const bf16_t*)(ws + WS_VWNT) + (size_t)bg * S * 128;
    const bf16_t* KS32 = (const bf16_t*)(ws + WS_KSL32) + (size_t)bg * S * 128; const bf16_t* VS32 = (const bf16_t*)(ws + WS_VSL32) + (size_t)bg * S * 128;
    const unsigned char* KSLb = (const unsigned char*)(ws + WS_KSL) + (size_t)bg * S * 128; const unsigned char* VSLb = (const unsigned char*)(ws + WS_VSLT) + (size_t)bg * S * 128;
    bf16_t* Y = (bf16_t*)(ws + WS_Y);
    LAS float* IMPL = (LAS float*)wl; LAS float* CARL = (LAS float*)(wl + 8192); LAS bf16_t* OCB = (LAS bf16_t*)wl; LAS bf16_t* OSB = (LAS bf16_t*)(wl + 8704); LAS int* SEL = (LAS int*)(wl + 17408); LAS float* LR = (LAS float*)(wl + 17920);
    const int b = bg >> 1, g = bg & 1, t0 = 8 * tile8;
    const int cur = t0 >> 6, nrest = cur >= 16 ? 13 : (cur > 2 ? cur - 2 : 0);
    const size_t tok0 = (size_t)b * S + t0;
    const int n = lane & 31, h = lane >> 5, ql = n >> 2, r = n & 3, lofs = lane * 8;
    const int tq = t0 + ql; const size_t tok = tok0 + ql;
    const bool has_cmp = t0 + 7 >= 31;
    const int cthi = has_cmp ? ((t0 + 7 - 31) >> 4) >> 5 : 0; const int clim = (tq >= 31) ? ((tq - 31) >> 4) : -1;
    float inv_c = 0.f;
    {
        bf16x8 q[8];
        const bf16_t* qp = QR + tok * 1024 + (4 * g + r) * 128 + 8 * h;
#pragma unroll
        for (int ks = 0; ks < 8; ++ks) q[ks] = *(const bf16x8*)(qp + 16 * ks);
        f32x16 Oc[4];
#pragma unroll
        for (int dt = 0; dt < 4; ++dt)
#pragma unroll
            for (int i = 0; i < 16; ++i) Oc[dt][i] = 0.f;
        if (has_cmp) {
            const float l = attn_pass1(KC, 0, cthi, q, -1, clim, lofs, h);
            inv_c = l > 0.f ? 1.f / l : 0.f;
            const float g0 = sigmoidf_(GL[tok * 24 + (4 * g + r) * 3 + 0]);
            if (cur >= 16) (void)attn_pass2<true, true, true>(KC, VCT, 0, cthi, q, -1, clim, inv_c, g0, Oc, IMPL, CARL, n, h, lofs);
            else (void)attn_pass2<false, true, true>(KC, VCT, 0, cthi, q, -1, clim, inv_c, g0, Oc, nullptr, nullptr, n, h, lofs);
        }
        LDS_WAIT();
        if (cur >= 16) {
#pragma unroll 1
            for (int qi = 0; qi < 8; ++qi) {
                LAS int* sel = SEL + qi * 16;
                int vb[4];
#pragma unroll
                for (int i = 0; i < 4; ++i) { const int j = lane + 64 * i; vb[i] = (j >= 1 && j <= cur - 2) ? __float_as_int(fmaxf(IMPL[qi * 256 + j] + CARL[qi * 256 + j], 0.f)) : -1; }
                int Tb = 0;
#pragma unroll 1
                for (int bit = 30; bit >= 0; --bit) {
                    const int cand = Tb | (1 << bit); int c = 0;
#pragma unroll
                    for (int i = 0; i < 4; ++i) c += __builtin_popcountll(__ballot(vb[i] >= cand));
                    if (c >= 13) Tb = cand;
                }
                int base = 0;
#pragma unroll
                for (int i = 0; i < 4; ++i) { const unsigned long long m = __ballot(vb[i] > Tb);
                    const int pre = __builtin_amdgcn_mbcnt_hi((unsigned)(m >> 32), __builtin_amdgcn_mbcnt_lo((unsigned)m, 0u));
                    if (vb[i] > Tb) sel[base + pre] = lane + 64 * i;
                    base += __builtin_popcountll(m); }
                const int need = 13 - base; int taken = 0;
#pragma unroll
                for (int i = 0; i < 4; ++i) { const unsigned long long m = __ballot(vb[i] == Tb);
                    const int pre = __builtin_amdgcn_mbcnt_hi((unsigned)(m >> 32), __builtin_amdgcn_mbcnt_lo((unsigned)m, 0u));
                    if (vb[i] == Tb && taken + pre < need) sel[base + taken + pre] = lane + 64 * i;
                    taken += __builtin_popcountll(m); }
            }
        } else if (lane < 13) {
#pragma unroll
            for (int qi = 0; qi < 8; ++qi) SEL[qi * 16 + lane] = lane + 1;
        }
        LDS_WAIT();
#pragma unroll
        for (int dt = 0; dt < 4; ++dt)
#pragma unroll
            for (int i4 = 0; i4 < 4; ++i4) { u32x2 w; w.x = pk2(Oc[dt][4 * i4], Oc[dt][4 * i4 + 1]); w.y = pk2(Oc[dt][4 * i4 + 2], Oc[dt][4 * i4 + 3]);
                *(LAS u32x2*)(OCB + n * 136 + 32 * dt + 8 * i4 + 4 * h) = w; }
        LDS_WAIT();
    }
    if (nrest > 0) {
        const int lb = opaque(lane);
        const int n16 = lb & 15, kq = lb >> 4, r16 = n16 & 3, lo16 = lb * 16;
        const int total = 8 * nrest;
        const unsigned char* qbase = (const unsigned char*)(ws + WS_QR8) + tok0 * 1024 + (4 * g + r16) * 128 + 8 * kq;
        u32x4 kA[8], vA[8]; u32x2 q16[4];
        int jcur = __builtin_amdgcn_readfirstlane(SEL[0]);
        {
            const unsigned char* Kp = KSLb + (size_t)jcur * 8192 + lo16; const unsigned char* Vp = VSLb + (size_t)jcur * 8192 + lo16;
#pragma unroll
            for (int i = 0; i < 8; ++i) kA[i] = *(const u32x4*)(Kp + i * 1024);
#pragma unroll
            for (int i = 0; i < 8; ++i) vA[i] = *(const u32x4*)(Vp + i * 1024);
#pragma unroll
            for (int ks = 0; ks < 4; ++ks) q16[ks] = *(const u32x2*)(qbase + 32 * ks);
        }
        f32x4 Os[8]; float l = 0.f;
#pragma unroll
        for (int dt = 0; dt < 8; ++dt) Os[dt] = (f32x4){0.f, 0.f, 0.f, 0.f};
        int qi = 0, si = 0;
#pragma unroll 1
        for (int f = 0; f < total; ++f) {
            int sn = si + 1, qn = qi; if (sn == nrest) { sn = 0; qn = qi + 1; }
            const bool hasn = f + 1 < total, lastb = (si == nrest - 1);
            const int jn = hasn ? __builtin_amdgcn_readfirstlane(SEL[qn * 16 + sn]) : jcur;
            f32x4 s[4];
            __builtin_amdgcn_s_setprio(1);
#pragma unroll
            for (int kt = 0; kt < 4; ++kt) { s[kt] = (f32x4){0.f, 0.f, 0.f, 0.f};
#pragma unroll
                for (int kp = 0; kp < 2; ++kp) { const u32x4 rw = kA[kt * 2 + kp];
                    s[kt] = MFMA16F8(mk64(rw.x, rw.y), mk64(q16[2 * kp].x, q16[2 * kp].y), s[kt]); s[kt] = MFMA16F8(mk64(rw.z, rw.w), mk64(q16[2 * kp + 1].x, q16[2 * kp + 1].y), s[kt]); } }
            __builtin_amdgcn_s_setprio(0);
            { const unsigned char* Kp = KSLb + (size_t)jn * 8192 + lo16;
#pragma unroll
                for (int i = 0; i < 8; ++i) kA[i] = *(const u32x4*)(Kp + i * 1024); }
            if (lastb && hasn) {
#pragma unroll
                for (int ks = 0; ks < 4; ++ks) q16[ks] = *(const u32x2*)(qbase + (size_t)qn * 1024 + 32 * ks);
            }
#pragma unroll
            for (int kt = 0; kt < 4; ++kt)
#pragma unroll
                for (int e = 0; e < 4; ++e) { const float ev = __builtin_amdgcn_exp2f(s[kt][e]); s[kt][e] = ev; l += ev; }
#pragma unroll
            for (int u = 0; u < 2; ++u) {
                u32x4 pw; pw.x = pk2(s[2 * u][0], s[2 * u][1]); pw.y = pk2(s[2 * u][2], s[2 * u][3]); pw.z = pk2(s[2 * u + 1][0], s[2 * u + 1][1]); pw.w = pk2(s[2 * u + 1][2], s[2 * u + 1][3]);
                const bf16x8 pb = __builtin_bit_cast(bf16x8, pw);
                __builtin_amdgcn_s_setprio(1);
#pragma unroll
                for (int dp = 0; dp < 4; ++dp) { const u32x4 rw = vA[u * 4 + dp];
                    Os[2 * dp] = MFMA16(fp8_frag(rw.x, rw.y), pb, Os[2 * dp]); Os[2 * dp + 1] = MFMA16(fp8_frag(rw.z, rw.w), pb, Os[2 * dp + 1]); }
                __builtin_amdgcn_s_setprio(0);
            }
            { const unsigned char* Vp = VSLb + (size_t)jn * 8192 + lo16;
#pragma unroll
                for (int i = 0; i < 8; ++i) vA[i] = *(const u32x4*)(Vp + i * 1024); }
            if (lastb) {
                l += __shfl_xor(l, 16); l += __shfl_xor(l, 32);
                if (n16 < 4) { LAS bf16_t* op = OSB + (qi * 4 + r16) * 136 + 4 * kq;
#pragma unroll
                    for (int dt = 0; dt < 8; ++dt) { u32x2 w; w.x = pk2(Os[dt].x, Os[dt].y); w.y = pk2(Os[dt].z, Os[dt].w); *(LAS u32x2*)(op + 16 * dt) = w; }
                    if (kq == 0) LR[qi * 4 + r16] = l; }
#pragma unroll
                for (int dt = 0; dt < 8; ++dt) Os[dt] = (f32x4){0.f, 0.f, 0.f, 0.f};
                l = 0.f;
            }
            si = sn; qi = qn; jcur = jn;
        }
    } else {
        const unsigned zz = (unsigned)opaque(0);
#pragma unroll
        for (int i = 0; i < 9; ++i) { const int idx = lane + 64 * i; if (idx < 32 * 136 / 8) *(LAS u32x4*)(OSB + 8 * idx) = (u32x4){zz, zz, zz, zz}; }
        if (lane < 32) LR[lane] = 0.f;
    }
    LDS_WAIT();
    {
        bf16x8 q[8];
        const bf16_t* qp = QR + tok * 1024 + (4 * g + r) * 128 + 8 * h;
#pragma unroll
        for (int ks = 0; ks < 8; ++ks) q[ks] = *(const bf16x8*)(qp + 16 * ks);
        const float* glp = GL + tok * 24 + (4 * g + r) * 3;
        const float g1 = sigmoidf_(glp[1]), g2 = sigmoidf_(glp[2]);
        f32x16 O[4];
#pragma unroll
        for (int dt = 0; dt < 4; ++dt)
#pragma unroll
            for (int i = 0; i < 16; ++i) O[dt][i] = 0.f;
        {
            const int lo_key = t0 - 511 > 0 ? t0 - 511 : 0; const int tlo = lo_key >> 5, thi = (t0 + 7) >> 5;
            float l = attn_pass2<false, true>(KW, VWT, tlo, thi, q, tq - 512, tq, 1.f, 1.f, O, nullptr, nullptr, n, h, lofs);
            l += __shfl_xor(l, 32);
            const float sc = g2 / l;
#pragma unroll
            for (int dt = 0; dt < 4; ++dt)
#pragma unroll
                for (int i = 0; i < 16; ++i) O[dt][i] *= sc;
        }
        {
            const int a_lo = 0, a_hi = cur >= 2 ? 1 : 2 * cur + 1, b_lo = 2 * cur - 2, b_hi = 2 * cur + 1; const bool two = cur >= 2;
            float lf = attn_pass1(KS32, a_lo, a_hi, q, -1, tq, lofs, h);
            if (two) lf += attn_pass1(KS32, b_lo, b_hi, q, -1, tq, lofs, h);
            const float lt = lf + LR[n];
            const float sc = g1 / lt;
            (void)attn_pass2<false, true>(KS32, VS32, a_lo, a_hi, q, -1, tq, 1.f, sc, O, nullptr, nullptr, n, h, lofs);
            if (two) (void)attn_pass2<false, true>(KS32, VS32, b_lo, b_hi, q, -1, tq, 1.f, sc, O, nullptr, nullptr, n, h, lofs);
            float ss = 0.f;
#pragma unroll
            for (int dt = 0; dt < 4; ++dt)
#pragma unroll
                for (int i4 = 0; i4 < 4; ++i4) { const int eo = n * 136 + 32 * dt + 8 * i4 + 4 * h;
                    const u32x2 pc = *(const LAS u32x2*)(OCB + eo), pb2 = *(const LAS u32x2*)(OSB + eo);
                    const float cv[4] = {__uint_as_float(pc.x << 16), __uint_as_float(pc.x & 0xffff0000u), __uint_as_float(pc.y << 16), __uint_as_float(pc.y & 0xffff0000u)};
                    const float bv[4] = {__uint_as_float(pb2.x << 16), __uint_as_float(pb2.x & 0xffff0000u), __uint_as_float(pb2.y << 16), __uint_as_float(pb2.y & 0xffff0000u)};
#pragma unroll
                    for (int e = 0; e < 4; ++e) { const float v = O[dt][4 * i4 + e] + cv[e] + bv[e] * sc; O[dt][4 * i4 + e] = v; ss += v * v; } }
            ss += __shfl_xor(ss, 32);
            const float rstd = rsqrtf(ss * (1.f / 128.f) + EPS);
            LDS_WAIT();
#pragma unroll
            for (int dt = 0; dt < 4; ++dt)
#pragma unroll
                for (int i4 = 0; i4 < 4; ++i4) { u32x2 w; w.x = pk2(O[dt][4 * i4] * rstd, O[dt][4 * i4 + 1] * rstd); w.y = pk2(O[dt][4 * i4 + 2] * rstd, O[dt][4 * i4 + 3] * rstd);
                    *(LAS u32x2*)(OCB + n * 136 + 32 * dt + 8 * i4 + 4 * h) = w; }
        }
        LDS_WAIT();
#pragma unroll 2
        for (int q8 = 0; q8 < 8; ++q8) { const int e = lane * 8, rr = e >> 7, d = e & 127;
            const u32x4 w = *(const LAS u32x4*)(OCB + (q8 * 4 + rr) * 136 + d);
            *(u32x4*)(Y + (tok0 + q8) * D + 1024 + 4 * g * 128 + e) = w; }
    }
    LDS_WAIT();
}

__global__ void __launch_bounds__(512, 2) hymba_fwd(Args a) {
    extern __shared__ __attribute__((aligned(16))) unsigned char lds_raw[];
    LAS unsigned char* lds = (LAS unsigned char*)lds_raw;
    cg::grid_group grid = cg::this_grid();
    const int tid0 = threadIdx.x, wave = __builtin_amdgcn_readfirstlane(tid0 >> 6), G = gridDim.x;
    const int gw = blockIdx.x * 8 + wave, NGW = G * 8;
    unsigned char* ws = a.ws;
    float* ADA = (float*)(ws + WS_ADA);
    bf16_t* XN = (bf16_t*)(ws + WS_XN);
    volatile LAS unsigned* bst = (volatile LAS unsigned*)(lds + 8 * WAVE_LDS);
    if (tid0 < 16) bst[tid0] = 0u;
    __syncthreads();
    const XcdBarrier xbar = xcd_barrier_post((unsigned*)(ws + WS_BAR), bst);

    { const int tid = opaque(tid0); p0_prologue(a, lds, tid, tid & 63, wave, G); }
    grid.sync();
    { const int lane = opaque(tid0) & 63;
      norm_mod_rows(a.in[I_X], a.in[I_NMIX], ADA, 0, 1, XN, gw, NGW, lane);
      bias13_rows((const bf16_t*)(ws + WS_W13), ADA, (float*)(ws + WS_BIAS13), gw, NGW, lane);
      float* sq = (float*)(ws + WS_SUMSQ); for (int i = blockIdx.x * 512 + opaque(tid0); i < T; i += G * 512) sq[i] = 0.f; }
    xcd_barrier(xbar);
    {
        pg8::Gemm g{XN, (const bf16_t*)(ws + WS_WIN), T, INWP, D, D}; pg8::StaticOrder so; so.init(T, INWP, G, (int)blockIdx.x, 4);
        pg8::EpiProj E{(bf16_t*)(ws + WS_CONVIN), (bf16_t*)(ws + WS_KV6), (float*)(ws + WS_GL)};
        pg8::gemm_phase<pg8::EpiProj, pg8::StaticOrder, true>(lds, g, so, E);
    }
    xcd_barrier(xbar);
    {
        const int NGEMM = (G >= 64) ? 32 : 0;
        if ((int)blockIdx.x < NGEMM) {
            const int kv = blockIdx.x >> 4;
            pg8::Gemm g{(const bf16_t*)(ws + WS_KV6) + (size_t)kv * 4 * S * 128, (const bf16_t*)(ws + (kv ? WS_CW1V : WS_CW1K)), 4096, 256, 4096, 2048};
            pg8::OneUnit ou{(int)(blockIdx.x & 15)};
            pg8::EpiHid E{(float*)(ws + WS_HID) + (size_t)kv * 4096 * 256, (const float*)(ws + WS_CB1) + kv * 256};
            pg8::gemm_phase<pg8::EpiHid, pg8::OneUnit, false>(lds, g, ou, E);
        } else {
            const int ew = (blockIdx.x - NGEMM) * 8 + wave, NEW = (G - NGEMM) * 8, lane = opaque(tid0) & 63;
            LAS unsigned char* wl = lds + wave * WAVE_LDS;
            conv_range(a, (const bf16_t*)(ws + WS_CONVIN), (bf16_t*)(ws + WS_Y), (int)((long)ew * T / NEW), (int)((long)(ew + 1) * T / NEW), lane);
            for (int it = ew; it < T; it += NEW) normrope_item(a, ws, it, lane);
            for (int it = ew; it < 3072; it += NEW) vtrans_item(ws, it >> 10, it & 1023, wl, lane);
        }
        if (NGEMM == 0) {
            for (int u = blockIdx.x; u < 32; u += G) { const int kv = u >> 4;
                pg8::Gemm g{(const bf16_t*)(ws + WS_KV6) + (size_t)kv * 4 * S * 128, (const bf16_t*)(ws + (kv ? WS_CW1V : WS_CW1K)), 4096, 256, 4096, 2048};
                pg8::OneUnit ou{u & 15}; pg8::EpiHid E{(float*)(ws + WS_HID) + (size_t)kv * 4096 * 256, (const float*)(ws + WS_CB1) + kv * 256};
                __syncthreads();
                pg8::gemm_phase<pg8::EpiHid, pg8::OneUnit, false>(lds, g, ou, E); }
        }
    }
    xcd_barrier(xbar);
    cmp2_phase(a, ws, lds, opaque(tid0), wave, G);
    xcd_barrier(xbar);
    {
        LAS unsigned char* wl = lds + wave * WAVE_LDS;
        unsigned* heads = (unsigned*)(ws + WS_BAR) + 3584;
        const int bg0 = (int)(blockIdx.x & 3);
#pragma unroll 1
        for (int sidx = 0; sidx < 4; ++sidx) {
            const int bg = (bg0 + sidx) & 3;
#pragma unroll 1
            for (;;) {
                int it = 0; if ((tid0 & 63) == 0) it = (int)atomicAdd(heads + 64 * bg, 1u); it = __builtin_amdgcn_readfirstlane(it);
                if (it >= 2048) break;
                attn_item(a, ws, wl, bg, 2047 - it, opaque(tid0) & 63);
            }
        }
    }
    xcd_barrier(xbar);
    {
        pg8::Gemm g{(const bf16_t*)(ws + WS_Y), (const bf16_t*)(ws + WS_WOUT), T, D, D, D}; pg8::StaticOrder so; so.init(T, D, G, (int)blockIdx.x, 4);
        pg8::EpiRes2 E{a.in[I_X], (bf16_t*)(ws + WS_X1B), ADA + 2 * 2048, a.in[I_NFFN], ADA + 4 * 2048, XN, (float*)(ws + WS_SUMSQ)};
        pg8::gemm_phase<pg8::EpiRes2, pg8::StaticOrder, true>(lds, g, so, E);
    }
    xcd_barrier(xbar);
    {
        pg8::Gemm g{XN, (const bf16_t*)(ws + WS_W13), T, 2 * DFF, D, D}; pg8::StaticOrder so; so.init(T, 2 * DFF, G, (int)blockIdx.x, 4);
        pg8::EpiSwiGLU E{(bf16_t*)(ws + WS_ACT), (const float*)(ws + WS_SUMSQ), (const float*)(ws + WS_BIAS13)};
        pg8::gemm_phase<pg8::EpiSwiGLU, pg8::StaticOrder, true>(lds, g, so, E);
    }
    xcd_barrier(xbar);
    {
        pg8::Gemm g{(const bf16_t*)(ws + WS_ACT), (const bf16_t*)(ws + WS_W2), T, D, DFF, DFF}; pg8::StaticOrder so; so.init(T, D, G, (int)blockIdx.x, 2);
        pg8::EpiRes E{(const bf16_t*)(ws + WS_X1B), a.out, ADA + 5 * 2048};
        pg8::gemm_phase<pg8::EpiRes, pg8::StaticOrder, true>(lds, g, so, E);
    }
}

extern "C" void kernel_launch(void* const* d_in, const int* in_sizes, int n_in, void* d_out, int out_size, void* d_ws, size_t ws_size, hipStream_t stream) {
    static int grid = 0;
    if (grid == 0) {
        if (n_in != 25 || out_size != T * D || ws_size < WS_END) { fprintf(stderr, "kernel_launch: unexpected shapes (n_in %d, out %d, ws %zu)\n", n_in, out_size, ws_size); grid = -1; return; }
        int dev = 0, cus = 0, per_cu = 0;
        hipGetDevice(&dev); hipDeviceGetAttribute(&cus, hipDeviceAttributeMultiprocessorCount, dev);
        hipFuncSetAttribute((const void*)hymba_fwd, hipFuncAttributeMaxDynamicSharedMemorySize, LDS_BYTES);
        if (hipOccupancyMaxActiveBlocksPerMultiprocessor(&per_cu, (const void*)hymba_fwd, 512, LDS_BYTES) != hipSuccess || per_cu < 1) per_cu = 1;
        (void)hipGetLastError();
        if (per_cu > 1) per_cu = 1;
        grid = cus * per_cu;
    }
    if (grid < 0) return;
    if (hipMemsetAsync((char*)d_ws + WS_BAR, 0, 16384, stream) != hipSuccess) { fprintf(stderr, "kernel_launch: memset of the barrier words failed\n"); return; }
    Args a{};
    for (int i = 0; i < 25; ++i) a.in[i] = (const float*)d_in[i];
    a.out = (float*)d_out; a.ws = (unsigned char*)d_ws;
    void* args[] = {&a};
    hipError_t e = hipLaunchCooperativeKernel((const void*)hymba_fwd, dim3(grid), dim3(512), args, LDS_BYTES, stream);
    if (e != hipSuccess) fprintf(stderr, "cooperative launch failed: %s (grid %d)\n", hipGetErrorString(e), grid);
}
```

```cpp
#include <hip/hip_runtime.h>
#include <hip/hip_cooperative_groups.h>
#include <cstdio>
#include <cstdint>
namespace cg = cooperative_groups;

#define DI __device__ __forceinline__
#define LAS __attribute__((address_space(3)))
typedef unsigned short bf16_t;
typedef short bf16x8 __attribute__((ext_vector_type(8)));
typedef float f32x2 __attribute__((ext_vector_type(2)));
typedef float f32x4 __attribute__((ext_vector_type(4)));
typedef float f32x16 __attribute__((ext_vector_type(16)));
typedef unsigned u32x2 __attribute__((ext_vector_type(2)));
typedef unsigned u32x4 __attribute__((ext_vector_type(4)));
typedef __bf16 bf16v2 __attribute__((ext_vector_type(2)));

constexpr int NB = 2, S = 16384, T = NB * S, D = 2048, CONVW = 1024, INW = 5656, INWP = 5888, DFF = 5632;
constexpr float EPS = 1e-6f;
constexpr size_t MiB = 1u << 20;
constexpr size_t WS_ADA = 0, WS_ROPE = 1 * MiB, WS_WIN = 17 * MiB, WS_WOUT = 40 * MiB, WS_W13 = 48 * MiB, WS_W2 = 92 * MiB,
                 WS_CW1K = 114 * MiB, WS_CW1V = 116 * MiB, WS_CB1 = 118 * MiB, WS_HID = 119 * MiB, WS_KCMP = 127 * MiB, WS_VCMPT = 128 * MiB,
                 WS_GL = 129 * MiB, WS_KV6 = 132 * MiB, WS_KSL = 230 * MiB, WS_KWN = 246 * MiB, WS_VSLT = 262 * MiB, WS_VWNT = 278 * MiB,
                 WS_QR = 294 * MiB, WS_CONVIN = 358 * MiB, WS_XN = 614 * MiB, WS_Y = 742 * MiB, WS_ACT = 230 * MiB, WS_QR8 = 870 * MiB, WS_KSL32 = 902 * MiB, WS_VSL32 = 918 * MiB, WS_X1B = 870 * MiB  , WS_END = 998 * MiB;
constexpr size_t WS_SUMSQ = WS_CB1 + 65536, WS_BIAS13 = WS_CB1 + 262144;
constexpr size_t WS_BAR = WS_CB1 + 524288;
constexpr int LDS_BYTES = 8 * 18048 + 64;
constexpr int WAVE_LDS = 18048;

DI unsigned pk2(float lo, float hi) { f32x2 v = {lo, hi}; bf16v2 b = __builtin_convertvector(v, bf16v2); return __builtin_bit_cast(unsigned, b); }
DI float bf2f(bf16_t v) { return __uint_as_float((unsigned)v << 16); }
DI float wsum64(float v) {
#pragma unroll
    for (int o = 1; o < 64; o <<= 1) v += __shfl_xor(v, o);
    return v;
}
DI float sigmoidf_(float x) { return __builtin_amdgcn_rcpf(1.f + __expf(-x)); }
#define LDS_WAIT() asm volatile("s_waitcnt lgkmcnt(0)" ::: "memory")
DI int opaque(int x) { asm volatile("" : "+v"(x)); return x; }

namespace pg8 {
constexpr int BM = 256, BK = 64, HALF = 128, HTB = HALF * BK * 2, STAGE_BYTES = 8 * HTB, NXCD = 8;
__host__ __device__ __forceinline__ int lds_byte(int r, int c) { const int st = (r >> 4) * 2 + (c >> 5), rr = r & 15, cc = c & 31, ob = rr * 64 + cc * 2; return st * 1024 + (ob ^ (((ob >> 9) & 1) << 5)); }
__host__ __device__ __forceinline__ void stage_rc(int b, int& R, int& C) { const int st = b / 1024, sb = b % 1024, swz = sb ^ (((sb >> 9) & 1) << 5); R = (st >> 1) * 16 + swz / 64; C = (st & 1) * 32 + (swz % 64) / 2; }
__host__ __device__ __forceinline__ int perm32(int rho) { const int n = rho >> 4, i = rho & 15; return 8 * (i >> 2) + 4 * n + (i & 3); }
struct Unit { int pm, pn; };
struct Gemm { const bf16_t* A; const bf16_t* Bt; int M, N, K, lda; };
struct StaticOrder {
    int nM, nN, nwg, G, c, WGM;
    __device__ void init(int M, int N, int G_, int c_, int wgm) { nM = M / BM; nN = N / BM; nwg = nM * nN; G = G_; c = c_; WGM = wgm; }
    __device__ bool next(int i, Unit& u) const {
        const long L = (long)i * G + c; if (L >= nwg) return false;
        int wgid = (int)L; { const int q = nwg / NXCD, r = nwg % NXCD, xcd = wgid % NXCD, off = wgid / NXCD; wgid = (xcd < r ? xcd * (q + 1) : r * (q + 1) + (xcd - r) * q) + off; }
        const int nig = WGM * nN, gid = wgid / nig, fm = gid * WGM, gsz = (nM - fm) < WGM ? (nM - fm) : WGM;
        u.pm = fm + ((wgid % nig) % gsz); u.pn = (wgid % nig) / gsz; return true;
    }
};
struct OneUnit { int pm; __device__ bool next(int i, Unit& u) const { if (i) return false; u.pm = pm; u.pn = 0; return true; } };

template <class Epi, class Sched, bool ALIGN_EPI>
DI void gemm_phase(LAS unsigned char* lds, const Gemm g, const Sched& S_, const Epi& E) {
    const int tid = opaque((int)threadIdx.x), wid = __builtin_amdgcn_readfirstlane(tid >> 6), lane = tid & 63, wr = wid >> 2, wc = wid & 3, fr = lane & 15, fq = lane >> 4;
    const int K = g.K, nt = K / BK, lda = g.lda;
    unsigned voffA[2], voffB[2];
#pragma unroll
    for (int i = 0; i < 2; ++i) { int R, C; stage_rc(tid * 16 + i * 8192, R, C); const int Rb = Epi::PERM ? ((R & ~31) + perm32(R & 31)) : R;
        voffA[i] = (unsigned)(R * lda + C) * 2u; voffB[i] = (unsigned)(Rb * K + C) * 2u; }
    const size_t kstep = (size_t)(BK * 2);
    const size_t hstepA = (size_t)HALF * lda * 2, hstepB = (size_t)HALF * K * 2;
    const size_t tstepA = 2 * hstepA, tstepB = 2 * hstepB;
    const unsigned ldsw = (unsigned)wid * 1024u;
    const int aoff = lds_byte(wr * 64 + fr, fq * 8), boff = lds_byte(wc * 32 + fr, fq * 8);
#define PG8_SA(b, h) (((b) * 2 + (h)) * HTB)
#define PG8_SB(b, h) ((4 + (b) * 2 + (h)) * HTB)
#define PG8_STAGE(bufoff, gbase, voff) do { _Pragma("unroll") for (int _i = 0; _i < 2; ++_i) \
        __builtin_amdgcn_global_load_lds((const unsigned*)((const char*)(gbase) + (voff)[_i]), (LAS unsigned*)(lds + (bufoff) + ldsw + _i * 8192), 16, 0, 0); } while (0)
#define PG8_LDA(dst, b, h) do { _Pragma("unroll") for (int m = 0; m < 4; ++m) _Pragma("unroll") for (int k = 0; k < 2; ++k) dst[m][k] = *(const LAS bf16x8*)(lds + PG8_SA(b, h) + aoff + m * 2048 + k * 1024); } while (0)
#define PG8_LDB(dst, b, h) do { _Pragma("unroll") for (int n = 0; n < 2; ++n) _Pragma("unroll") for (int k = 0; k < 2; ++k) dst[n][k] = *(const LAS bf16x8*)(lds + PG8_SB(b, h) + boff + n * 2048 + k * 1024); } while (0)
#define PG8_MMA(ai, bj, At, Bt) do { __builtin_amdgcn_s_setprio(1); _Pragma("unroll") for (int m = 0; m < 4; ++m) _Pragma("unroll") for (int n = 0; n < 2; ++n) _Pragma("unroll") for (int k = 0; k < 2; ++k) \
        acc[ai][bj][m][n] = __builtin_amdgcn_mfma_f32_16x16x32_bf16(Bt[n][k], At[m][k], acc[ai][bj][m][n], 0, 0, 0); __builtin_amdgcn_s_setprio(0); } while (0)
#define PG8_WAIT_V(n) asm volatile("s_waitcnt vmcnt(" #n ")" ::: "memory")
#define PG8_WAIT_L(n) asm volatile("s_waitcnt lgkmcnt(" #n ")" ::: "memory")
#define PG8_BAR __builtin_amdgcn_s_barrier()
#define PG8_SCHED __builtin_amdgcn_sched_barrier(0)
    Unit cur, nxt; int ui = 0;
    if (!S_.next(0, cur)) return;
    f32x4 acc[2][2][4][2];
#pragma unroll
    for (int a = 0; a < 2; ++a)
#pragma unroll
        for (int b = 0; b < 2; ++b)
#pragma unroll
            for (int m = 0; m < 4; ++m)
#pragma unroll
                for (int n = 0; n < 2; ++n) acc[a][b][m][n] = (f32x4){0.f, 0.f, 0.f, 0.f};
    bf16x8 At[4][2], B0[2][2], B1[2][2];
    const char* cA = (const char*)g.A + (size_t)cur.pm * tstepA; const char* cB = (const char*)g.Bt + (size_t)cur.pn * tstepB;
    PG8_STAGE(PG8_SB(0, 0), cB, voffB); PG8_STAGE(PG8_SB(0, 1), cB + hstepB, voffB); PG8_STAGE(PG8_SA(0, 0), cA, voffA); PG8_STAGE(PG8_SA(0, 1), cA + hstepA, voffA);
    if (wr == 1) PG8_BAR;
    PG8_WAIT_V(2); PG8_BAR;
    PG8_STAGE(PG8_SB(1, 0), cB + kstep, voffB); PG8_STAGE(PG8_SA(1, 0), cA + kstep, voffA); PG8_STAGE(PG8_SB(1, 1), cB + hstepB + kstep, voffB);
    PG8_WAIT_V(6); PG8_BAR;
    for (;;) {
        const bool has_next = S_.next(ui + 1, nxt);
        const char* nA = has_next ? (const char*)g.A + (size_t)nxt.pm * tstepA : cA; const char* nB = has_next ? (const char*)g.Bt + (size_t)nxt.pn * tstepB : cB;
        for (int t = 0; t < nt; t += 2) {
            const bool last = (t == nt - 2);
            const char* a1 = cA + (size_t)(t + 1) * kstep;
            const char* a2 = last ? nA : cA + (size_t)(t + 2) * kstep; const char* b2 = last ? nB : cB + (size_t)(t + 2) * kstep;
            const char* a3 = a2 + kstep; const char* b3 = b2 + kstep;
            PG8_LDB(B0, 0, 0); PG8_LDB(B1, 0, 1); PG8_SCHED; PG8_LDA(At, 0, 0); PG8_STAGE(PG8_SA(1, 1), a1 + hstepA, voffA);
            PG8_WAIT_V(8); PG8_WAIT_L(0); PG8_BAR; PG8_MMA(0, 0, At, B0); PG8_MMA(0, 1, At, B1); PG8_BAR; PG8_SCHED;
            PG8_LDA(At, 0, 1); PG8_STAGE(PG8_SB(0, 0), b2, voffB); PG8_STAGE(PG8_SB(0, 1), b2 + hstepB, voffB); PG8_STAGE(PG8_SA(0, 0), a2, voffA);
            PG8_WAIT_V(8); PG8_WAIT_L(0); PG8_BAR; PG8_MMA(1, 0, At, B0); PG8_MMA(1, 1, At, B1); PG8_BAR; PG8_SCHED;
            PG8_LDB(B0, 1, 0); PG8_LDB(B1, 1, 1); PG8_SCHED; PG8_LDA(At, 1, 0); PG8_STAGE(PG8_SA(0, 1), a2 + hstepA, voffA);
            PG8_WAIT_V(8); PG8_WAIT_L(0); PG8_BAR; PG8_MMA(0, 0, At, B0); PG8_MMA(0, 1, At, B1); PG8_BAR; PG8_SCHED;
            PG8_LDA(At, 1, 1); PG8_STAGE(PG8_SB(1, 0), b3, voffB); PG8_STAGE(PG8_SB(1, 1), b3 + hstepB, voffB); PG8_STAGE(PG8_SA(1, 0), a3, voffA);
            PG8_WAIT_V(8); PG8_WAIT_L(0); PG8_BAR; PG8_MMA(1, 0, At, B0); PG8_MMA(1, 1, At, B1); PG8_BAR; PG8_SCHED;
        }
        if constexpr (ALIGN_EPI) { if (wr == 0) PG8_BAR; }
        E(acc, cur, wr, wc, fr, fq);
        if (!has_next) break;
#pragma unroll
        for (int a = 0; a < 2; ++a)
#pragma unroll
            for (int b = 0; b < 2; ++b)
#pragma unroll
                for (int m = 0; m < 4; ++m)
#pragma unroll
                    for (int n = 0; n < 2; ++n) acc[a][b][m][n] = (f32x4){0.f, 0.f, 0.f, 0.f};
        cur = nxt; cA = nA; cB = nB; ++ui;
        if constexpr (ALIGN_EPI) { if (wr == 1) PG8_BAR; }
    }
    PG8_WAIT_V(0);
    if constexpr (!ALIGN_EPI) { if (wr == 0) PG8_BAR; }
    PG8_BAR;
#undef PG8_SA
#undef PG8_SB
#undef PG8_STAGE
#undef PG8_LDA
#undef PG8_LDB
#undef PG8_MMA
#undef PG8_WAIT_V
#undef PG8_WAIT_L
#undef PG8_BAR
#undef PG8_SCHED
}

struct EpiProj {
    static constexpr bool PERM = true;
    bf16_t* convin; bf16_t* kv6; float* gl;
    DI void operator()(const f32x4 (&acc)[2][2][4][2], const Unit& u, int wr, int wc, int fr, int fq) const {
        const int row0 = u.pm * BM + wr * 64 + fr;
#pragma unroll
        for (int ai = 0; ai < 2; ++ai)
#pragma unroll
            for (int m = 0; m < 4; ++m) {
                const int row = row0 + ai * HALF + m * 16;
#pragma unroll
                for (int bj = 0; bj < 2; ++bj) {
                    const f32x4 v0 = acc[ai][bj][m][0], v1 = acc[ai][bj][m][1];
                    u32x4 w; w.x = pk2(v0[0], v0[1]); w.y = pk2(v0[2], v0[3]); w.z = pk2(v1[0], v1[1]); w.w = pk2(v1[2], v1[3]);
                    if (u.pn < 16) {
                        *(u32x4*)(convin + (size_t)row * 4096 + u.pn * 256 + bj * HALF + wc * 32 + 8 * fq) = w;
                    } else if (u.pn < 22) {
                        const int ti = u.pn - 16, b = row >> 14, s = row & (S - 1);
                        *(u32x4*)(kv6 + ((size_t)((ti * 4 + b * 2 + bj)) * S + s) * 128 + wc * 32 + 8 * fq) = w;
                    } else if (bj == 0 && wc == 0 && fq < 3) {
                        *(f32x4*)(gl + (size_t)row * 24 + 8 * fq) = v0; *(f32x4*)(gl + (size_t)row * 24 + 8 * fq + 4) = v1;
                    }
                }
            }
    }
};
struct EpiHid {
    static constexpr bool PERM = true;
    float* hid; const float* bias;
    DI void operator()(const f32x4 (&acc)[2][2][4][2], const Unit& u, int wr, int wc, int fr, int fq) const {
        const int row0 = u.pm * BM + wr * 64 + fr;
#pragma unroll
        for (int bj = 0; bj < 2; ++bj) {
            const int col = bj * HALF + wc * 32 + 8 * fq;
            const f32x4 b0 = *(const f32x4*)(bias + col), b1 = *(const f32x4*)(bias + col + 4);
#pragma unroll
            for (int ai = 0; ai < 2; ++ai)
#pragma unroll
                for (int m = 0; m < 4; ++m) {
                    const int row = row0 + ai * HALF + m * 16;
                    f32x4 v0 = acc[ai][bj][m][0] + b0, v1 = acc[ai][bj][m][1] + b1;
#pragma unroll
                    for (int e = 0; e < 4; ++e) {
                        float x = v0[e]; float z = 0.7978845608f * (x + 0.044715f * x * x * x); v0[e] = x * __builtin_amdgcn_rcpf(1.f + __expf(-2.f * z));
                        x = v1[e]; z = 0.7978845608f * (x + 0.044715f * x * x * x); v1[e] = x * __builtin_amdgcn_rcpf(1.f + __expf(-2.f * z));
                    }
                    *(f32x4*)(hid + (size_t)row * 256 + col) = v0; *(f32x4*)(hid + (size_t)row * 256 + col + 4) = v1;
                }
        }
    }
};
struct EpiRes {
    static constexpr bool PERM = true;
    const bf16_t* base; float* out; const float* gate;
    DI void operator()(const f32x4 (&acc)[2][2][4][2], const Unit& u, int wr, int wc, int fr, int fq) const {
        const int row0 = u.pm * BM + wr * 64 + fr, col0 = u.pn * BM + wc * 32 + 8 * fq;
        const int b = (u.pm * BM) >> 14;
#pragma unroll
        for (int bj = 0; bj < 2; ++bj) {
            const int col = col0 + bj * HALF;
            const f32x4 g0 = *(const f32x4*)(gate + (size_t)b * 12288 + col), g1 = *(const f32x4*)(gate + (size_t)b * 12288 + col + 4);
#pragma unroll
            for (int ai = 0; ai < 2; ++ai)
#pragma unroll
                for (int m = 0; m < 4; ++m) {
                    const size_t off = (size_t)(row0 + ai * HALF + m * 16) * D + col;
                    const u32x4 bw = *(const u32x4*)(base + off);
                    const f32x4 b0 = {__uint_as_float(bw.x << 16), __uint_as_float(bw.x & 0xffff0000u), __uint_as_float(bw.y << 16), __uint_as_float(bw.y & 0xffff0000u)};
                    const f32x4 b1 = {__uint_as_float(bw.z << 16), __uint_as_float(bw.z & 0xffff0000u), __uint_as_float(bw.w << 16), __uint_as_float(bw.w & 0xffff0000u)};
                    *(f32x4*)(out + off) = b0 + g0 * acc[ai][bj][m][0]; *(f32x4*)(out + off + 4) = b1 + g1 * acc[ai][bj][m][1];
                }
        }
    }
};
struct EpiRes2 {
    static constexpr bool PERM = true;
    const float* base; bf16_t* out; const float* gate; const float* gain; const float* scl; bf16_t* xs; float* sumsq;
    DI void operator()(const f32x4 (&acc)[2][2][4][2], const Unit& u, int wr, int wc, int fr, int fq) const {
        const int row0 = u.pm * BM + wr * 64 + fr, col0 = u.pn * BM + wc * 32 + 8 * fq;
        const int b = (u.pm * BM) >> 14;
        float ss[2][4];
#pragma unroll
        for (int ai = 0; ai < 2; ++ai)
#pragma unroll
            for (int m = 0; m < 4; ++m) ss[ai][m] = 0.f;
#pragma unroll
        for (int bj = 0; bj < 2; ++bj) {
            const int col = col0 + bj * HALF;
            const f32x4 gv0 = *(const f32x4*)(gate + (size_t)b * 12288 + col), gv1 = *(const f32x4*)(gate + (size_t)b * 12288 + col + 4);
            const f32x4 gm0 = *(const f32x4*)(gain + col) * (*(const f32x4*)(scl + (size_t)b * 12288 + col) + 1.f), gm1 = *(const f32x4*)(gain + col + 4) * (*(const f32x4*)(scl + (size_t)b * 12288 + col + 4) + 1.f);
#pragma unroll
            for (int ai = 0; ai < 2; ++ai)
#pragma unroll
                for (int m = 0; m < 4; ++m) {
                    const size_t off = (size_t)(row0 + ai * HALF + m * 16) * D + col;
                    const f32x4 xa = *(const f32x4*)(base + off) + gv0 * acc[ai][bj][m][0], xb = *(const f32x4*)(base + off + 4) + gv1 * acc[ai][bj][m][1];
                    { u32x4 w1; w1.x = pk2(xa.x, xa.y); w1.y = pk2(xa.z, xa.w); w1.z = pk2(xb.x, xb.y); w1.w = pk2(xb.z, xb.w); *(u32x4*)(out + off) = w1; }
                    ss[ai][m] += ((xa.x * xa.x + xa.y * xa.y) + (xa.z * xa.z + xa.w * xa.w)) + ((xb.x * xb.x + xb.y * xb.y) + (xb.z * xb.z + xb.w * xb.w));
                    const f32x4 ma = xa * gm0, mb = xb * gm1; u32x4 w; w.x = pk2(ma.x, ma.y); w.y = pk2(ma.z, ma.w); w.z = pk2(mb.x, mb.y); w.w = pk2(mb.z, mb.w);
                    *(u32x4*)(xs + off) = w;
                }
        }
#pragma unroll
        for (int ai = 0; ai < 2; ++ai)
#pragma unroll
            for (int m = 0; m < 4; ++m) { float v = ss[ai][m]; v += __shfl_xor(v, 16); v += __shfl_xor(v, 32);
                if (fq == 0) atomicAdd(sumsq + row0 + ai * HALF + m * 16, v); }
    }
};
struct EpiSwiGLU {
    static constexpr bool PERM = true;
    bf16_t* act; const float* sumsq; const float* bias;
    DI void operator()(const f32x4 (&acc)[2][2][4][2], const Unit& u, int wr, int wc, int fr, int fq) const {
        const int row0 = u.pm * BM + wr * 64 + fr, col = u.pn * HALF + wc * 32 + 8 * fq;
        const int b = (u.pm * BM) >> 14;
        const float* bp = bias + (size_t)b * (2 * DFF) + u.pn * BM + wc * 32 + 8 * fq;
        const f32x4 ba0 = *(const f32x4*)bp, ba1 = *(const f32x4*)(bp + 4), bb0 = *(const f32x4*)(bp + HALF), bb1 = *(const f32x4*)(bp + HALF + 4);
#pragma unroll
        for (int ai = 0; ai < 2; ++ai)
#pragma unroll
            for (int m = 0; m < 4; ++m) {
                const int row = row0 + ai * HALF + m * 16;
                const float rstd = rsqrtf(sumsq[row] * (1.f / D) + EPS);
                float o[8];
#pragma unroll
                for (int n = 0; n < 2; ++n)
#pragma unroll
                    for (int e = 0; e < 4; ++e) { const float a = acc[ai][0][m][n][e] * rstd + (n ? ba1[e] : ba0[e]), bv = acc[ai][1][m][n][e] * rstd + (n ? bb1[e] : bb0[e]);
                        o[4 * n + e] = a * __builtin_amdgcn_rcpf(1.f + __expf(-a)) * bv; }
                u32x4 w; w.x = pk2(o[0], o[1]); w.y = pk2(o[2], o[3]); w.z = pk2(o[4], o[5]); w.w = pk2(o[6], o[7]);
                *(u32x4*)(act + (size_t)row * DFF + col) = w;
            }
    }
};
}

#define XB_TMO      128
#define XB_XCNT(j)  (256  + 64 * (j))
#define XB_XSUB(j)  (1280 + 64 * (j))
#define XB_XGEN(j)  (2304 + 64 * (j))
#define XB_TOP      3328
#define XB_TOPGEN   3392
#define XCD_BAR_WORDS 3456
#define XB_SPIN_CAP (1u << 18)

__device__ __forceinline__ unsigned xb_ld(unsigned* p)              { return __hip_atomic_load(p, __ATOMIC_RELAXED, __HIP_MEMORY_SCOPE_AGENT); }
__device__ __forceinline__ unsigned xb_add(unsigned* p, unsigned v) { return __hip_atomic_fetch_add(p, v, __ATOMIC_RELAXED, __HIP_MEMORY_SCOPE_AGENT); }
__device__ __forceinline__ unsigned xb_xcc_id() { return (unsigned)__builtin_amdgcn_s_getreg((3 << 11) | 20) & 0xFu; }
#define XB_SPIN(cond, bar) do { unsigned _sp = 0; while (cond) { __builtin_amdgcn_s_sleep(1); \
    if ((++_sp & 255u) == 0u) { if (xb_ld(&(bar)[XB_TMO])) break; if (_sp > XB_SPIN_CAP) { atomicAdd(&(bar)[XB_TMO], 1u); break; } } } } while (0)

struct XcdBarrier {
    unsigned* bar; unsigned x;
    volatile LAS unsigned* st;
};

__device__ __forceinline__ XcdBarrier xcd_barrier_post(unsigned* bar, volatile LAS unsigned* st) {
    XcdBarrier b; b.bar = bar; b.x = xb_xcc_id(); b.st = st;
    if (threadIdx.x == 0) (void)xb_add(&bar[XB_XCNT(b.x)], 1u);
    return b;
}
__device__ __forceinline__ void xcd_barrier_complete(unsigned* bar, unsigned x, unsigned& nloc, unsigned& nx) {
    const unsigned G = gridDim.x * gridDim.y * gridDim.z;
    unsigned sum, cnt, mine, sp = 0u;
    for (;;) {
        sum = 0u; cnt = 0u; mine = 0u;
#pragma unroll
        for (unsigned j = 0; j < 16; ++j) { const unsigned c = xb_ld(&bar[XB_XCNT(j)]); sum += c; cnt += (c > 0u) ? 1u : 0u; mine = (j == x) ? c : mine; }
        if (sum == G) break;
        __builtin_amdgcn_s_sleep(1);
        if ((++sp & 255u) == 0u) { if (xb_ld(&bar[XB_TMO])) break; if (sp > XB_SPIN_CAP) { atomicAdd(&bar[XB_TMO], 1u); break; } }
    }
    nloc = mine > 0u ? mine : 1u; nx = cnt > 0u ? cnt : 1u;
}

__device__ __forceinline__ void xcd_barrier(const XcdBarrier& b) {
    asm volatile("s_waitcnt vmcnt(0)" ::: "memory");
    __syncthreads();
    if (threadIdx.x == 0) {
        unsigned* bar = b.bar;
        __builtin_amdgcn_s_waitcnt(0);
        unsigned nloc = b.st[0], nx = b.st[1];
        if (nloc == 0u) { xcd_barrier_complete(bar, b.x, nloc, nx); b.st[0] = nloc; b.st[1] = nx; }
        const unsigned old = xb_add(&bar[XB_XSUB(b.x)], 1u);
        const unsigned gen = old / nloc;
        if (old + 1u == (gen + 1u) * nloc) {
            __builtin_amdgcn_fence(__ATOMIC_RELEASE, "agent");
            asm volatile("s_waitcnt vmcnt(0)" ::: "memory");
            const unsigned og = xb_add(&bar[XB_TOP], 1u);
            const unsigned tg = og / nx;
            if (og + 1u == (tg + 1u) * nx) xb_add(&bar[XB_TOPGEN], 1u);
            else XB_SPIN(xb_ld(&bar[XB_TOPGEN]) == tg, bar);
            __builtin_amdgcn_fence(__ATOMIC_ACQUIRE, "agent");
            xb_add(&bar[XB_XGEN(b.x)], 1u);
            asm volatile("s_waitcnt vmcnt(0)" ::: "memory");
        } else {
            XB_SPIN(xb_ld(&bar[XB_XGEN(b.x)]) == gen, bar);
            __builtin_amdgcn_fence(__ATOMIC_ACQUIRE, "agent");
            asm volatile("s_waitcnt vmcnt(0)" ::: "memory");
        }
    }
    __syncthreads();
}


struct Args { const float* in[25]; float* out; unsigned char* ws; };
enum { I_X = 0, I_C, I_POS, I_ADAW, I_ADAB, I_NMIX, I_NFFN, I_WIN, I_CONVW, I_PEK, I_KW1, I_KB1, I_KW2, I_PEV, I_VW1, I_VB1, I_VW2, I_QN, I_KN, I_ONC, I_ONA, I_WOUT, I_W1, I_W3, I_W2 };

DI void transpose_item(const float* W, int K, int N, bf16_t* WT, int mode, LAS float* scr, int item, int lane, const float* kscA = nullptr, const float* kscB = nullptr) {
    const int nblk = (N + 63) / 64, kb = item / nblk, nb = item % nblk, k0 = 64 * kb, n0 = 64 * nb;
    const int nn = n0 + lane; const bool okc = nn < N;
    const float* wp = W + (size_t)k0 * N + (okc ? nn : 0);
#pragma unroll 16
    for (int i = 0; i < 64; ++i) { const int kg = k0 + i; float v = wp[(size_t)i * N]; if (kscA) v *= (kg < 1024 ? kscA[kg] : kscB[kg - 1024]); scr[i * 65 + lane] = okc ? v : 0.f; }
    LDS_WAIT();
    const int c = lane & 7;
#pragma unroll
    for (int j = 0; j < 8; ++j) { const int n = (lane >> 3) + 8 * j; const LAS float* sp = scr + (8 * c) * 65 + n;
        u32x4 o; o.x = pk2(sp[0 * 65], sp[1 * 65]); o.y = pk2(sp[2 * 65], sp[3 * 65]); o.z = pk2(sp[4 * 65], sp[5 * 65]); o.w = pk2(sp[6 * 65], sp[7 * 65]);
        const int ng = n0 + n;
        if (ng < N) { const int row = mode == 0 ? ng : (256 * (ng >> 7) + (ng & 127) + (mode == 2 ? 128 : 0)); *(u32x4*)(WT + (size_t)row * K + k0 + 8 * c) = o; } }
    LDS_WAIT();
}

DI void p0_prologue(const Args& a, LAS unsigned char* lds, int tid, int lane, int wave, int G) {
    unsigned char* ws = a.ws;
    const int gw = blockIdx.x * 8 + wave, NGW = G * 8;
    float* ADA = (float*)(ws + WS_ADA); float* CB1 = (float*)(ws + WS_CB1);
    LAS float* red = (LAS float*)lds;
    for (int task = blockIdx.x; task < 100; task += G) {
        const float *W, *v0, *v1, *bias; float *o0, *o1; int K, N, col0; bool dosilu;
        if (task < 96) { W = a.in[I_ADAW]; K = 2048; N = 12288; col0 = task * 128; v0 = a.in[I_C]; v1 = a.in[I_C] + 2048; dosilu = true; bias = a.in[I_ADAB] + col0; o0 = ADA + col0; o1 = ADA + 12288 + col0; }
        else { const int kv = (task - 96) >> 1, cgp = (task - 96) & 1; W = a.in[kv ? I_VW1 : I_KW1]; K = 4096; N = 256; col0 = cgp * 128; v0 = a.in[kv ? I_PEV : I_PEK]; v1 = nullptr; dosilu = false;
            bias = a.in[kv ? I_VB1 : I_KB1] + col0; o0 = CB1 + kv * 256 + col0; o1 = nullptr; }
        LAS float* vec = (LAS float*)(lds + 8192);
        for (int i = tid; i < K; i += 512) { float c0 = v0[i]; if (dosilu) c0 = c0 * __builtin_amdgcn_rcpf(1.f + __expf(-c0)); vec[i] = c0;
            float c1 = 0.f; if (v1) { c1 = v1[i]; c1 = c1 * __builtin_amdgcn_rcpf(1.f + __expf(-c1)); } vec[4096 + i] = c1; }
        __syncthreads();
        const int kper = K / 8; f32x2 a0 = {0.f, 0.f}, a1 = {0.f, 0.f};
        const float* wp = W + (size_t)(wave * kper) * N + col0 + 2 * lane;
        const LAS float* vp = vec + wave * kper;
#pragma unroll 16
        for (int k = 0; k < kper; ++k) { const f32x2 w = *(const f32x2*)(wp + (size_t)k * N); a0 += w * vp[k]; a1 += w * vp[4096 + k]; }
        *(LAS f32x2*)(red + (wave * 2 + 0) * 128 + 2 * lane) = a0; *(LAS f32x2*)(red + (wave * 2 + 1) * 128 + 2 * lane) = a1;
        __syncthreads();
        if (wave < 2) { float s0 = 0.f, s1 = 0.f;
#pragma unroll
            for (int w = 0; w < 8; ++w) { s0 += red[(w * 2 + wave) * 128 + lane]; s1 += red[(w * 2 + wave) * 128 + 64 + lane]; }
            float* op = wave ? o1 : o0; if (op) { op[lane] = s0 + bias[lane]; op[64 + lane] = s1 + bias[64 + lane]; } }
        __syncthreads();
    }
    { float* RC = (float*)(ws + WS_ROPE); float* RS = RC + (size_t)T * 64; const int* pos = (const int*)a.in[I_POS];
      for (int idx = gw * 64 + lane; idx < T * 64; idx += NGW * 64) { const int t = idx >> 6, i = idx & 63;
          const float inv = 1.0f / exp2f((float)i * (13.287712379549449f / 64.f)); const float ang = (float)pos[t] * inv;
          const double rev = (double)ang * 0.15915494309189535; const float fr = (float)(rev - __builtin_rint(rev));
          RC[idx] = __builtin_amdgcn_cosf(fr); RS[idx] = __builtin_amdgcn_sinf(fr); } }
    { LAS float* scr = (LAS float*)(lds + wave * WAVE_LDS);
      bf16_t* WinT = (bf16_t*)(ws + WS_WIN); bf16_t* WoutT = (bf16_t*)(ws + WS_WOUT); bf16_t* W13T = (bf16_t*)(ws + WS_W13); bf16_t* W2T = (bf16_t*)(ws + WS_W2);
      bf16_t* CW1K = (bf16_t*)(ws + WS_CW1K); bf16_t* CW1V = (bf16_t*)(ws + WS_CW1V);
      constexpr int I_IN = 32 * 89, I_O = 32 * 32, I_F1 = 32 * 88, I_F2 = 88 * 32, I_C1 = 64 * 4;
      constexpr int NITEMS = I_IN + I_O + 2 * I_F1 + I_F2 + 2 * I_C1;
      unsigned* qctr = (unsigned*)(ws + WS_BAR) + 3520;
      for (;;) { int it = 0; if (lane == 0) it = (int)atomicAdd(qctr, 1u); it = __builtin_amdgcn_readfirstlane(it); if (it >= NITEMS) break; int r = it;
          if (r < I_IN) { transpose_item(a.in[I_WIN], D, INW, WinT, 0, scr, r, lane); continue; } r -= I_IN;
          if (r < I_O) { transpose_item(a.in[I_WOUT], D, D, WoutT, 0, scr, r, lane, a.in[I_ONC], a.in[I_ONA]); continue; } r -= I_O;
          if (r < I_F1) { transpose_item(a.in[I_W1], D, DFF, W13T, 1, scr, r, lane); continue; } r -= I_F1;
          if (r < I_F1) { transpose_item(a.in[I_W3], D, DFF, W13T, 2, scr, r, lane); continue; } r -= I_F1;
          if (r < I_F2) { transpose_item(a.in[I_W2], DFF, D, W2T, 0, scr, r, lane); continue; } r -= I_F2;
          if (r < I_C1) { transpose_item(a.in[I_KW1], 4096, 256, CW1K, 0, scr, r, lane); continue; } r -= I_C1;
          transpose_item(a.in[I_VW1], 4096, 256, CW1V, 0, scr, r, lane); }
      u32x4* z = (u32x4*)(WinT + (size_t)INW * D); const int nz = (INWP - INW) * D / 8;
      for (int i = blockIdx.x * 512 + tid; i < nz; i += G * 512) z[i] = (u32x4){0u, 0u, 0u, 0u}; }
}

DI void norm_mod_rows(const float* src, const float* gain, const float* ada, int shi, int sci, bf16_t* dst, int gw, int NGW, int lane) {
    f32x4 gm[8], sh[8]; int bprev = -1;
    for (int m = gw; m < T; m += NGW) {
        const int b = m >> 14;
        if (b != bprev) { bprev = b;
#pragma unroll
            for (int j = 0; j < 8; ++j) { const int col = 4 * lane + 256 * j;
                gm[j] = *(const f32x4*)(gain + col) * (*(const f32x4*)(ada + b * 12288 + sci * 2048 + col) + 1.f); sh[j] = *(const f32x4*)(ada + b * 12288 + shi * 2048 + col); } }
        const f32x4* xr = (const f32x4*)(src + (size_t)m * D) + lane;
        f32x4 v[8]; float s = 0.f;
#pragma unroll
        for (int j = 0; j < 8; ++j) { v[j] = xr[64 * j]; s += (v[j].x * v[j].x + v[j].y * v[j].y) + (v[j].z * v[j].z + v[j].w * v[j].w); }
        const float rstd = rsqrtf(wsum64(s) * (1.f / D) + EPS);
#pragma unroll
        for (int j = 0; j < 8; ++j) { const int col = 4 * lane + 256 * j;
            const f32x4 o = v[j] * rstd * gm[j] + sh[j];
            u32x2 w; w.x = pk2(o.x, o.y); w.y = pk2(o.z, o.w);
            *(u32x2*)(dst + (size_t)m * D + col) = w; }
    }
}

DI void bias13_rows(const bf16_t* W13T, const float* ada, float* bias13, int gw, int NGW, int lane) {
    for (int n = gw; n < 2 * DFF; n += NGW) {
        float s0 = 0.f, s1 = 0.f;
#pragma unroll
        for (int j = 0; j < 4; ++j) { const int k = 8 * (lane + 64 * j); const u32x4 w = *(const u32x4*)(W13T + (size_t)n * D + k);
#pragma unroll
            for (int e = 0; e < 4; ++e) { const float wa = __uint_as_float(w[e] << 16), wb = __uint_as_float(w[e] & 0xffff0000u);
                s0 += wa * ada[3 * 2048 + k + 2 * e] + wb * ada[3 * 2048 + k + 2 * e + 1];
                s1 += wa * ada[12288 + 3 * 2048 + k + 2 * e] + wb * ada[12288 + 3 * 2048 + k + 2 * e + 1]; } }
        s0 = wsum64(s0); s1 = wsum64(s1);
        if (lane == 0) { bias13[n] = s0; bias13[2 * DFF + n] = s1; }
    }
}

DI float dpp_x1(float v) { return __int_as_float(__builtin_amdgcn_update_dpp(0, __float_as_int(v), 0xB1, 0xF, 0xF, false)); }
DI float dpp_x2(float v) { return __int_as_float(__builtin_amdgcn_update_dpp(0, __float_as_int(v), 0x4E, 0xF, 0xF, false)); }
DI float dpp_r4(float v) { return __int_as_float(__builtin_amdgcn_update_dpp(0, __float_as_int(v), 0x124, 0xF, 0xF, false)); }
DI float dpp_r8(float v) { return __int_as_float(__builtin_amdgcn_update_dpp(0, __float_as_int(v), 0x128, 0xF, 0xF, false)); }
DI float row16_sum(float v) { v += dpp_x1(v); v += dpp_x2(v); v += dpp_r4(v); v += dpp_r8(v); return v; }
DI void conv_range(const Args& a, const bf16_t* CIN, bf16_t* Y, int tb, int te, int lane) {
    const float* cw = a.in[I_CONVW];
#pragma unroll 1
    for (int c2 = 0; c2 < 2; ++c2) {
        const int ch0 = 512 * c2 + 8 * lane;
        float w0[8], w1[8], w2[8], u1[8], u2[8];
#pragma unroll
        for (int e = 0; e < 8; ++e) { w0[e] = cw[ch0 + e]; w1[e] = cw[1024 + ch0 + e]; w2[e] = cw[2048 + ch0 + e]; u1[e] = 0.f; u2[e] = 0.f; }
#pragma unroll
        for (int back = 2; back >= 1; --back) {
            if ((tb & (S - 1)) >= back) {
                const bf16_t* rp = CIN + (size_t)(tb - back) * 4096;
                const u32x4 cc = *(const u32x4*)(rp + 1024 + ch0), hh = *(const u32x4*)(rp + 2048 + ch0);
#pragma unroll
                for (int e = 0; e < 4; ++e) { const float ca = __uint_as_float(cc[e] << 16), cb_ = __uint_as_float(cc[e] & 0xffff0000u), ha = __uint_as_float(hh[e] << 16), hb = __uint_as_float(hh[e] & 0xffff0000u);
                    if (back == 2) { u2[2 * e] = ca * ha; u2[2 * e + 1] = cb_ * hb; } else { u1[2 * e] = ca * ha; u1[2 * e + 1] = cb_ * hb; } }
            }
        }
#pragma unroll 4
        for (int t = tb; t < te; ++t) {
            if ((t & (S - 1)) == 0) {
#pragma unroll
                for (int e = 0; e < 8; ++e) { u1[e] = 0.f; u2[e] = 0.f; } }
            const bf16_t* rp = CIN + (size_t)t * 4096;
            const u32x4 bb = *(const u32x4*)(rp + ch0), cc = *(const u32x4*)(rp + 1024 + ch0), hh = *(const u32x4*)(rp + 2048 + ch0);
            float y[8]; float ss = 0.f;
#pragma unroll
            for (int e = 0; e < 4; ++e) {
                const float ca = __uint_as_float(cc[e] << 16), cb_ = __uint_as_float(cc[e] & 0xffff0000u), ha = __uint_as_float(hh[e] << 16), hb = __uint_as_float(hh[e] & 0xffff0000u);
                const float ba = __uint_as_float(bb[e] << 16), bbb = __uint_as_float(bb[e] & 0xffff0000u);
                const float ua = ca * ha, ub = cb_ * hb;
                y[2 * e] = ba * (w0[2 * e] * u2[2 * e] + w1[2 * e] * u1[2 * e] + w2[2 * e] * ua);
                y[2 * e + 1] = bbb * (w0[2 * e + 1] * u2[2 * e + 1] + w1[2 * e + 1] * u1[2 * e + 1] + w2[2 * e + 1] * ub);
                u2[2 * e] = u1[2 * e]; u2[2 * e + 1] = u1[2 * e + 1]; u1[2 * e] = ua; u1[2 * e + 1] = ub;
                ss += y[2 * e] * y[2 * e] + y[2 * e + 1] * y[2 * e + 1];
            }
            ss = row16_sum(ss);
            const float rstd = rsqrtf(ss * (1.f / 128.f) + EPS);
            u32x4 w; w.x = pk2(y[0] * rstd, y[1] * rstd); w.y = pk2(y[2] * rstd, y[3] * rstd);
            w.z = pk2(y[4] * rstd, y[5] * rstd); w.w = pk2(y[6] * rstd, y[7] * rstd);
            *(u32x4*)(Y + (size_t)t * D + ch0) = w;
        }
    }
}
DI int perm_slc(int p) { const int q = p & 31; return (p & 32) | (((q >> 2) & 1) << 4) | ((q >> 3) << 2) | (q & 3); }
DI int perm_w16(int p) { return (p & ~15) | (p & 3) | ((p & 4) << 1) | ((p & 8) >> 1); }
DI size_t k32_off(int n, int d) { return (size_t)(n >> 5) * 4096 + (d >> 4) * 512 + ((((d & 15) >> 3) * 32) + (n & 31)) * 8 + (d & 7); }
DI size_t k16_off(int s, int d) { return (size_t)(s >> 6) * 8192 + ((s >> 4) & 3) * 2048 + (d >> 5) * 512 + (s & 15) * 32 + (d & 31); }
DI unsigned fp8x2(float a, float b) { return (unsigned)__builtin_amdgcn_cvt_pk_fp8_f32(a, b, 0, false) & 0xffffu; }
DI bf16x8 fp8_frag(unsigned w0, unsigned w1) {
    u32x4 o;
    o.x = __builtin_bit_cast(unsigned, __builtin_amdgcn_cvt_scalef32_pk_bf16_fp8(w0, 1.0f, false)); o.y = __builtin_bit_cast(unsigned, __builtin_amdgcn_cvt_scalef32_pk_bf16_fp8(w0, 1.0f, true));
    o.z = __builtin_bit_cast(unsigned, __builtin_amdgcn_cvt_scalef32_pk_bf16_fp8(w1, 1.0f, false)); o.w = __builtin_bit_cast(unsigned, __builtin_amdgcn_cvt_scalef32_pk_bf16_fp8(w1, 1.0f, true));
    return __builtin_bit_cast(bf16x8, o);
}
DI size_t k8_off(int s_, int d) { return (size_t)(s_ >> 6) * 8192 + (((s_ >> 4) & 3) * 2 + (d >> 6)) * 1024 + ((((d & 31) >> 3) * 16) + (s_ & 15)) * 16 + ((d >> 5) & 1) * 8 + (d & 7); }
constexpr float QSCALE = 0.08838834764831845f * 1.4426950408889634f;
DI void normrope_item(const Args& a, unsigned char* ws, int tok, int lane) {
    const bf16_t* CIN = (const bf16_t*)(ws + WS_CONVIN); const bf16_t* KV6 = (const bf16_t*)(ws + WS_KV6);
    const int b = tok >> 14, s = tok & (S - 1), hsub = lane >> 4, l16 = lane & 15, d0 = 8 * l16;
    const float* RC = (const float*)(ws + WS_ROPE) + (size_t)tok * 64 + (d0 & 63); const float* RS = RC + (size_t)T * 64;
    const f32x4 c0 = *(const f32x4*)RC, c1 = *(const f32x4*)(RC + 4), s0 = *(const f32x4*)RS, s1 = *(const f32x4*)(RS + 4);
    const float cs[8] = {c0.x, c0.y, c0.z, c0.w, c1.x, c1.y, c1.z, c1.w};
    const float sgn = l16 < 8 ? -1.f : 1.f;
    const float sn[8] = {s0.x * sgn, s0.y * sgn, s0.z * sgn, s0.w * sgn, s1.x * sgn, s1.y * sgn, s1.z * sgn, s1.w * sgn};
#pragma unroll
    for (int p = 0; p < 3; ++p) {
        const bf16_t* src; const float* gain; float scale = 1.f; int kind;
        int head;
        if (p < 2) { head = 4 * p + hsub; kind = 0; src = CIN + (size_t)tok * 4096 + 3072 + head * 128 + d0; gain = a.in[I_QN]; scale = QSCALE; }
        else if (hsub < 2) { head = hsub; kind = 1; src = KV6 + ((size_t)(2 * 4 + b * 2 + head) * S + s) * 128 + d0; gain = a.in[I_KN] + 128; }
        else { head = hsub - 2; kind = 2; src = KV6 + ((size_t)(4 * 4 + b * 2 + head) * S + s) * 128 + d0; gain = a.in[I_KN] + 256; }
        const u32x4 raw = *(const u32x4*)src;
        const f32x4 g0 = *(const f32x4*)(gain + d0), g1 = *(const f32x4*)(gain + d0 + 4);
        const float gg[8] = {g0.x, g0.y, g0.z, g0.w, g1.x, g1.y, g1.z, g1.w};
        float x[8]; float ss = 0.f;
#pragma unroll
        for (int e = 0; e < 4; ++e) { x[2 * e] = __uint_as_float(raw[e] << 16); x[2 * e + 1] = __uint_as_float(raw[e] & 0xffff0000u); ss += x[2 * e] * x[2 * e] + x[2 * e + 1] * x[2 * e + 1]; }
        const float rstd = rsqrtf(row16_sum(ss) * (1.f / 128.f) + EPS);
        float o[8];
#pragma unroll
        for (int e = 0; e < 8; ++e) { const float y = x[e] * rstd * gg[e]; const float pr = dpp_r8(y); o[e] = (y * cs[e] + pr * sn[e]) * scale; }
        u32x4 wb; wb.x = pk2(o[0], o[1]); wb.y = pk2(o[2], o[3]); wb.z = pk2(o[4], o[5]); wb.w = pk2(o[6], o[7]);
        u32x2 w8; w8.x = fp8x2(o[0], o[1]) | (fp8x2(o[2], o[3]) << 16); w8.y = fp8x2(o[4], o[5]) | (fp8x2(o[6], o[7]) << 16);
        if (kind == 0) {
            *(u32x4*)((bf16_t*)(ws + WS_QR) + (size_t)tok * 1024 + head * 128 + d0) = wb;
            *(u32x2*)((unsigned char*)(ws + WS_QR8) + (size_t)tok * 1024 + head * 128 + d0) = w8;
        } else if (kind == 1) {
            *(u32x2*)((unsigned char*)(ws + WS_KSL) + (size_t)(b * 2 + head) * S * 128 + k8_off(s, d0)) = w8;
            *(u32x4*)((bf16_t*)(ws + WS_KSL32) + (size_t)(b * 2 + head) * S * 128 + k32_off(s, d0)) = wb;
        } else {
            *(u32x4*)((bf16_t*)(ws + WS_KWN) + (size_t)(b * 2 + head) * S * 128 + k32_off(s, d0)) = wb;
        }
    }
}
DI void vtrans_item(unsigned char* ws, int mode, int item, LAS unsigned char* scr, int lane) {
    const bf16_t* KV6 = (const bf16_t*)(ws + WS_KV6);
    const int bg = item >> 8, blk = item & 255;
    const bf16_t* src = KV6 + ((size_t)((mode == 1 ? 5 : 3) * 4 + bg) * S + 64 * blk) * 128;
#pragma unroll 4
    for (int i = 0; i < 16; ++i) { const int c = lane + 64 * i, key = c >> 4, dc = c & 15;
        *(LAS u32x4*)(scr + key * 272 + dc * 16) = *(const u32x4*)(src + (size_t)key * 128 + dc * 8); }
    LDS_WAIT();
    if (mode) {
        bf16_t* dstb = (bf16_t*)(ws + (mode == 1 ? WS_VWNT : WS_VSL32)) + ((size_t)bg * 256 + blk) * 8192;
#pragma unroll 4
        for (int i = 0; i < 16; ++i) { const int c = lane + 64 * i, d = c >> 3, pc = c & 7;
            unsigned w[4];
#pragma unroll
            for (int e = 0; e < 4; ++e) { const int p0 = 8 * pc + 2 * e, k0 = perm_w16(p0), k1 = perm_w16(p0 + 1);
                const unsigned lo = *(const LAS bf16_t*)(scr + k0 * 272 + d * 2), hi = *(const LAS bf16_t*)(scr + k1 * 272 + d * 2); w[e] = lo | (hi << 16); }
            const size_t off = (size_t)(pc >> 2) * 4096 + ((pc >> 1) & 1) * 2048 + (d >> 5) * 512 + ((pc & 1) * 32 + (d & 31)) * 8;
            *(u32x4*)(dstb + off) = (u32x4){w[0], w[1], w[2], w[3]}; }
    } else {
        unsigned char* dstb = (unsigned char*)(ws + WS_VSLT) + ((size_t)bg * 256 + blk) * 8192;
#pragma unroll 4
        for (int i = 0; i < 16; ++i) { const int c = lane + 64 * i, d = c >> 3, pc = c & 7;
            unsigned w[4];
#pragma unroll
            for (int e = 0; e < 4; ++e) { const int p0 = 8 * pc + 2 * e, k0 = perm_slc(p0), k1 = perm_slc(p0 + 1);
                const float lo = bf2f(*(const LAS bf16_t*)(scr + k0 * 272 + d * 2)), hi = bf2f(*(const LAS bf16_t*)(scr + k1 * 272 + d * 2)); w[e] = fp8x2(lo, hi); }
            const size_t off = (size_t)((pc >> 2) * 4 + (d >> 5)) * 1024 + ((pc & 3) * 16 + (d & 15)) * 16 + ((d >> 4) & 1) * 8;
            *(u32x2*)(dstb + off) = (u32x2){w[0] | (w[1] << 16), w[2] | (w[3] << 16)}; }
    }
    LDS_WAIT();
}

DI void cmp2_row(const Args& a, const unsigned char* ws, const LAS float* w2s, int kv, int m, int lane) {
    const int bg = m >> 10, n = m & 1023;
    bf16_t* KC = (bf16_t*)(ws + WS_KCMP) + (size_t)bg * 131072; bf16_t* VT = (bf16_t*)(ws + WS_VCMPT) + (size_t)bg * 131072;
    float o1 = 0.f, o2 = 0.f;
    if (n < 1023) {
        const float* hid = (const float*)(ws + WS_HID) + ((size_t)kv * 4096 + m) * 256;
        const f32x4 hv4 = *(const f32x4*)(hid + 4 * lane);
#pragma unroll 4
        for (int h4 = 0; h4 < 64; ++h4) {
#pragma unroll
            for (int e = 0; e < 4; ++e) { const float hv = __int_as_float(__builtin_amdgcn_readlane(__float_as_int(hv4[e]), h4));
                o1 += hv * w2s[(4 * h4 + e) * 128 + lane]; o2 += hv * w2s[(4 * h4 + e) * 128 + 64 + lane]; } }
    }
    if (kv == 0) {
        float ss = wsum64(o1 * o1 + o2 * o2); const float rstd = rsqrtf(ss * (1.f / 128.f) + EPS);
        const float* gain = a.in[I_KN]; o1 *= rstd * gain[lane]; o2 *= rstd * gain[64 + lane];
        const int b = bg >> 1, tok = b * S + ((n < 1023) ? 16 * n + 31 : 0);
        const float* RC = (const float*)(ws + WS_ROPE) + (size_t)tok * 64; const float* RS = RC + (size_t)T * 64;
        const float c = RC[lane], sn = RS[lane];
        const float r1 = o1 * c - o2 * sn, r2 = o2 * c + o1 * sn;
        KC[k32_off(n, lane)] = (bf16_t)(pk2(r1, 0.f) & 0xffffu); KC[k32_off(n, 64 + lane)] = (bf16_t)(pk2(r2, 0.f) & 0xffffu);
    } else {
        const int pp = perm_w16(n & 15);
        const size_t base = (size_t)(n >> 5) * 4096 + ((n >> 4) & 1) * 2048 + ((pp >> 3) * 32 + (lane & 31)) * 8 + (pp & 7);
        VT[base + (lane >> 5) * 512] = (bf16_t)(pk2(o1, 0.f) & 0xffffu);
        VT[base + (2 + (lane >> 5)) * 512] = (bf16_t)(pk2(o2, 0.f) & 0xffffu);
    }
}
DI void cmp2_phase(const Args& a, const unsigned char* ws, LAS unsigned char* lds, int tid, int wave, int G) {
    const int lane = tid & 63;
    for (int kv = 0; kv < 2; ++kv) {
        if (G > 1 && (int)(blockIdx.x & 1) != kv) continue;
        const int nb = G > 1 ? (G + 1 - kv) / 2 : 1, bi = G > 1 ? (int)(blockIdx.x >> 1) : 0;
        const float* w2 = a.in[kv ? I_VW2 : I_KW2];
        __syncthreads();
        for (int i = tid; i < 8192; i += 512) *(LAS f32x4*)(lds + i * 16) = *(const f32x4*)(w2 + 4 * i);
        __syncthreads();
        for (int m = bi * 8 + wave; m < 4096; m += nb * 8) cmp2_row(a, ws, (const LAS float*)lds, kv, m, lane);
    }
    __syncthreads();
}

#define MFMA32(a, b, c) __builtin_amdgcn_mfma_f32_32x32x16_bf16((a), (b), (c), 0, 0, 0)
#define MFMA16(a, b, c) __builtin_amdgcn_mfma_f32_16x16x32_bf16((a), (b), (c), 0, 0, 0)
#define MFMA16F8(a, b, c) __builtin_amdgcn_mfma_f32_16x16x32_fp8_fp8((a), (b), (c), 0, 0, 0)
DI long mk64(unsigned lo, unsigned hi) { return (long)(((unsigned long long)hi << 32) | lo); }
DI void ld8(bf16x8 (&k)[8], const bf16_t* p) {
#pragma unroll
    for (int i = 0; i < 8; ++i) k[i] = *(const bf16x8*)(p + i * 512);
}
DI f32x16 qk32(const bf16x8 (&k)[8], const bf16x8 (&q)[8]) {
    f32x16 s;
#pragma unroll
    for (int i = 0; i < 16; ++i) s[i] = 0.f;
    __builtin_amdgcn_s_setprio(1);
#pragma unroll
    for (int ks = 0; ks < 8; ++ks) s = MFMA32(k[ks], q[ks], s);
    __builtin_amdgcn_s_setprio(0);
    return s;
}
DI void pass1_tile(const bf16_t* Kb, int tile, int tnext, bf16x8 (&kc)[8], bf16x8 (&kn)[8], const bf16x8 (&q)[8], int limlo, int limhi, int lofs, int h, float& l) {
    ld8(kn, Kb + (size_t)tnext * 4096 + lofs);
    const int key0 = 32 * tile; const f32x16 s = qk32(kc, q);
#pragma unroll
    for (int i = 0; i < 16; ++i) { const int key = key0 + 8 * (i >> 2) + 4 * h + (i & 3); l += (key <= limhi && key > limlo) ? __builtin_amdgcn_exp2f(s[i]) : 0.f; }
}
DI float attn_pass1(const bf16_t* Kb, int tlo, int thi, const bf16x8 (&q)[8], int limlo, int limhi, int lofs, int h) {
    float l = 0.f; bf16x8 ka[8], kb[8]; ld8(ka, Kb + (size_t)tlo * 4096 + lofs);
    int tile = tlo;
#pragma unroll 1
    for (; tile < thi; tile += 2) {
        pass1_tile(Kb, tile, tile + 1, ka, kb, q, limlo, limhi, lofs, h, l);
        pass1_tile(Kb, tile + 1, tile + 2 <= thi ? tile + 2 : tile + 1, kb, ka, q, limlo, limhi, lofs, h, l);
    }
    if (tile == thi) pass1_tile(Kb, tile, tile, ka, kb, q, limlo, limhi, lofs, h, l);
    return l + __shfl_xor(l, 32);
}
template <bool IMP, bool PV, bool SB = false>
DI void pass2_tile(const bf16_t* Kb, const bf16_t* VTb, int tile, int tnext, bf16x8 (&kc)[8], bf16x8 (&kn)[8], const bf16x8 (&q)[8], int limlo, int limhi, float inv, float gate,
                   f32x16 (&O)[4], LAS float* imp, LAS float* car, int n, int h, int lofs, float& l) {
    bf16x8 vf[8]; if (PV) ld8(vf, VTb + (size_t)tile * 4096 + lofs);
    if (!SB) ld8(kn, Kb + (size_t)tnext * 4096 + lofs);
    const int key0 = 32 * tile; const f32x16 s = qk32(kc, q);
    if (SB) ld8(kc, Kb + (size_t)tnext * 4096 + lofs);
    const float pscale = IMP ? inv : inv * gate, pgate = IMP ? gate : 1.f;
    float p[16];
#pragma unroll
    for (int i = 0; i < 16; ++i) { const int key = key0 + 8 * (i >> 2) + 4 * h + (i & 3); p[i] = (key <= limhi && key > limlo) ? __builtin_amdgcn_exp2f(s[i]) * pscale : 0.f; l += p[i]; }
    if (PV) {
#pragma unroll
        for (int u = 0; u < 2; ++u) {
            u32x4 pw; pw.x = pk2(p[8 * u] * pgate, p[8 * u + 1] * pgate); pw.y = pk2(p[8 * u + 2] * pgate, p[8 * u + 3] * pgate);
            pw.z = pk2(p[8 * u + 4] * pgate, p[8 * u + 5] * pgate); pw.w = pk2(p[8 * u + 6] * pgate, p[8 * u + 7] * pgate);
            const bf16x8 pb = __builtin_bit_cast(bf16x8, pw);
            __builtin_amdgcn_s_setprio(1);
#pragma unroll
            for (int dt = 0; dt < 4; ++dt) O[dt] = MFMA32(vf[4 * u + dt], pb, O[dt]);
            __builtin_amdgcn_s_setprio(0);
        }
    }
    if (IMP) {
#pragma unroll
        for (int i4 = 0; i4 < 4; ++i4) {
            float P4 = (p[4 * i4] + p[4 * i4 + 1]) + (p[4 * i4 + 2] + p[4 * i4 + 3]), pl = p[4 * i4 + 3];
            P4 += dpp_x1(P4); P4 += dpp_x2(P4); pl += dpp_x1(pl); pl += dpp_x2(pl);
            if ((n & 3) == 0) { const int j = 8 * tile + 2 * i4 + h, ql = n >> 2; imp[ql * 256 + j] = P4; if (j + 1 < 256) car[ql * 256 + j + 1] = pl; }
        }
    }
}
template <bool IMP, bool PV, bool SB = false>
DI float attn_pass2(const bf16_t* Kb, const bf16_t* VTb, int tlo, int thi, const bf16x8 (&q)[8], int limlo, int limhi, float inv, float gate,
                   f32x16 (&O)[4], LAS float* imp, LAS float* car, int n, int h, int lofs) {
    float l = 0.f;
    if constexpr (SB) {
        bf16x8 kc[8]; ld8(kc, Kb + (size_t)tlo * 4096 + lofs);
#pragma unroll 1
        for (int tile = tlo; tile <= thi; ++tile) pass2_tile<IMP, PV, true>(Kb, VTb, tile, tile < thi ? tile + 1 : tile, kc, kc, q, limlo, limhi, inv, gate, O, imp, car, n, h, lofs, l);
        return l;
    }
    bf16x8 ka[8], kb[8]; ld8(ka, Kb + (size_t)tlo * 4096 + lofs);
    int tile = tlo;
#pragma unroll 1
    for (; tile < thi; tile += 2) {
        pass2_tile<IMP, PV>(Kb, VTb, tile, tile + 1, ka, kb, q, limlo, limhi, inv, gate, O, imp, car, n, h, lofs, l);
        pass2_tile<IMP, PV>(Kb, VTb, tile + 1, tile + 2 <= thi ? tile + 2 : tile + 1, kb, ka, q, limlo, limhi, inv, gate, O, imp, car, n, h, lofs, l);
    }
    if (tile == thi) pass2_tile<IMP, PV>(Kb, VTb, tile, tile, ka, kb, q, limlo, limhi, inv, gate, O, imp, car, n, h, lofs, l);
    return l;
}

DI void attn_item(const Args& a, const unsigned char* ws, LAS unsigned char* wl, int bg, int tile8, int lane) {
    const bf16_t* QR = (const bf16_t*)(ws + WS_QR); const float* GL = (const float*)(ws + WS_GL);
    const bf16_t* KC = (const bf16_t*)(ws + WS_KCMP) + (size_t)bg * 131072; const bf16_t* VCT = (const bf16_t*)(ws + WS_VCMPT) + (size_t)bg * 131072;
    const bf16_t* KW = (const bf16_t*)(ws + WS_KWN) + (size_t)bg * S * 128; const bf16_t* VWT = (const bf16_t*)(ws + WS_VWNT) + (size_t)bg * S * 128;
    const bf16_t* KS32 = (const bf16_t*)(ws + WS_KSL32) + (size_t)bg * S * 128; const bf16_t* VS32 = (const bf16_t*)(ws + WS_VSL32) + (size_t)bg * S * 128;
    const unsigned char* KSLb = (const unsigned char*)(ws + WS_KSL) + (size_t)bg * S * 128; const unsigned char* VSLb = (const unsigned char*)(ws + WS_VSLT) + (size_t)bg * S * 128;
    bf16_t* Y = (bf16_t*)(ws + WS_Y);
    LAS float* IMPL = (LAS float*)wl; LAS float* CARL = (LAS float*)(wl + 8192); LAS bf16_t* OCB = (LAS bf16_t*)wl; LAS bf16_t* OSB = (LAS bf16_t*)(wl + 8704); LAS int* SEL = (LAS int*)(wl + 17408); LAS float* LR = (LAS float*)(wl + 17920);
    const int b = bg >> 1, g = bg & 1, t0 = 8 * tile8;
    const int cur = t0 >> 6, nrest = cur >= 16 ? 13 : (cur > 2 ? cur - 2 : 0);
    const size_t tok0 = (size_t)b * S + t0;
    const int n = lane & 31, h = lane >> 5, ql = n >> 2, r = n & 3, lofs = lane * 8;
    const int tq = t0 + ql; const size_t tok = tok0 + ql;
    const bool has_cmp = t0 + 7 >= 31;
    const int cthi = has_cmp ? ((t0 + 7 - 31) >> 4) >> 5 : 0; const int clim = (tq >= 31) ? ((tq - 31) >> 4) : -1;
    float inv_c = 0.f;
    {
        bf16x8 q[8];
        const bf16_t* qp = QR + tok * 1024 + (4 * g + r) * 128 + 8 * h;
#pragma unroll
        for (int ks = 0; ks < 8; ++ks) q[ks] = *(const bf16x8*)(qp + 16 * ks);
        f32x16 Oc[4];
#pragma unroll
        for (int dt = 0; dt < 4; ++dt)
#pragma unroll
            for (int i = 0; i < 16; ++i) Oc[dt][i] = 0.f;
        if (has_cmp) {
            const float l = attn_pass1(KC, 0, cthi, q, -1, clim, lofs, h);
            inv_c = l > 0.f ? 1.f / l : 0.f;
            const float g0 = sigmoidf_(GL[tok * 24 + (4 * g + r) * 3 + 0]);
            if (cur >= 16) (void)attn_pass2<true, true, true>(KC, VCT, 0, cthi, q, -1, clim, inv_c, g0, Oc, IMPL, CARL, n, h, lofs);
            else (void)attn_pass2<false, true, true>(KC, VCT, 0, cthi, q, -1, clim, inv_c, g0, Oc, nullptr, nullptr, n, h, lofs);
        }
        LDS_WAIT();
        if (cur >= 16) {
#pragma unroll 1
            for (int qi = 0; qi < 8; ++qi) {
                LAS int* sel = SEL + qi * 16;
                int vb[4];
#pragma unroll
                for (int i = 0; i < 4; ++i) { const int j = lane + 64 * i; vb[i] = (j >= 1 && j <= cur - 2) ? __float_as_int(fmaxf(IMPL[qi * 256 + j] + CARL[qi * 256 + j], 0.f)) : -1; }
                int Tb = 0;
#pragma unroll 1
                for (int bit = 30; bit >= 0; --bit) {
                    const int cand = Tb | (1 << bit); int c = 0;
#pragma unroll
                    for (int i = 0; i < 4; ++i) c += __builtin_popcountll(__ballot(vb[i] >= cand));
                    if (c >= 13) Tb = cand;
                }
                int base = 0;
#pragma unroll
                for (int i = 0; i < 4; ++i) { const unsigned long long m = __ballot(vb[i] > Tb);
                    const int pre = __builtin_amdgcn_mbcnt_hi((unsigned)(m >> 32), __builtin_amdgcn_mbcnt_lo((unsigned)m, 0u));
                    if (vb[i] > Tb) sel[base + pre] = lane + 64 * i;
                    base += __builtin_popcountll(m); }
                const int need = 13 - base; int taken = 0;
#pragma unroll
                for (int i = 0; i < 4; ++i) { const unsigned long long m = __ballot(vb[i] == Tb);
                    const int pre = __builtin_amdgcn_mbcnt_hi((unsigned)(m >> 32), __builtin_amdgcn_mbcnt_lo((unsigned)m, 0u));
                    if (vb[i] == Tb && taken + pre < need) sel[base + taken + pre] = lane + 64 * i;
                    taken += __builtin_popcountll(m); }
            }
        } else if (lane < 13) {
#pragma unroll
            for (int qi = 0; qi < 8; ++qi) SEL[qi * 16 + lane] = lane + 1;
        }
        LDS_WAIT();
#pragma unroll
        for (int dt = 0; dt < 4; ++dt)
#pragma unroll
            for (int i4 = 0; i4 < 4; ++i4) { u32x2 w; w.x = pk2(Oc[dt][4 * i4], Oc[dt][4 * i4 + 1]); w.y = pk2(Oc[dt][4 * i4 + 2], Oc[dt][4 * i4 + 3]);
                *(LAS u32x2*)(OCB + n * 136 + 32 * dt + 8 * i4 + 4 * h) = w; }
        LDS_WAIT();
    }
    if (nrest > 0) {
        const int lb = opaque(lane);
        const int n16 = lb & 15, kq = lb >> 4, r16 = n16 & 3, lo16 = lb * 16;
        const int total = 8 * nrest;
        const unsigned char* qbase = (const unsigned char*)(ws + WS_QR8) + tok0 * 1024 + (4 * g + r16) * 128 + 8 * kq;
        u32x4 kA[8], vA[8]; u32x2 q16[4];
        int jcur = __builtin_amdgcn_readfirstlane(SEL[0]);
        {
            const unsigned char* Kp = KSLb + (size_t)jcur * 8192 + lo16; const unsigned char* Vp = VSLb + (size_t)jcur * 8192 + lo16;
#pragma unroll
            for (int i = 0; i < 8; ++i) kA[i] = *(const u32x4*)(Kp + i * 1024);
#pragma unroll
            for (int i = 0; i < 8; ++i) vA[i] = *(const u32x4*)(Vp + i * 1024);
#pragma unroll
            for (int ks = 0; ks < 4; ++ks) q16[ks] = *(const u32x2*)(qbase + 32 * ks);
        }
        f32x4 Os[8]; float l = 0.f;
#pragma unroll
        for (int dt = 0; dt < 8; ++dt) Os[dt] = (f32x4){0.f, 0.f, 0.f, 0.f};
        int qi = 0, si = 0;
#pragma unroll 1
        for (int f = 0; f < total; ++f) {
            int sn = si + 1, qn = qi; if (sn == nrest) { sn = 0; qn = qi + 1; }
            const bool hasn = f + 1 < total, lastb = (si == nrest - 1);
            const int jn = hasn ? __builtin_amdgcn_readfirstlane(SEL[qn * 16 + sn]) : jcur;
            f32x4 s[4];
            __builtin_amdgcn_s_setprio(1);
#pragma unroll
            for (int kt = 0; kt < 4; ++kt) { s[kt] = (f32x4){0.f, 0.f, 0.f, 0.f};
#pragma unroll
                for (int kp = 0; kp < 2; ++kp) { const u32x4 rw = kA[kt * 2 + kp];
                    s[kt] = MFMA16F8(mk64(rw.x, rw.y), mk64(q16[2 * kp].x, q16[2 * kp].y), s[kt]); s[kt] = MFMA16F8(mk64(rw.z, rw.w), mk64(q16[2 * kp + 1].x, q16[2 * kp + 1].y), s[kt]); } }
            __builtin_amdgcn_s_setprio(0);
            { const unsigned char* Kp = KSLb + (size_t)jn * 8192 + lo16;
#pragma unroll
                for (int i = 0; i < 8; ++i) kA[i] = *(const u32x4*)(Kp + i * 1024); }
            if (lastb && hasn) {
#pragma unroll
                for (int ks = 0; ks < 4; ++ks) q16[ks] = *(const u32x2*)(qbase + (size_t)qn * 1024 + 32 * ks);
            }
#pragma unroll
            for (int kt = 0; kt < 4; ++kt)
#pragma unroll
                for (int e = 0; e < 4; ++e) { const float ev = __builtin_amdgcn_exp2f(s[kt][e]); s[kt][e] = ev; l += ev; }
#pragma unroll
            for (int u = 0; u < 2; ++u) {
                u32x4 pw; pw.x = pk2(s[2 * u][0], s[2 * u][1]); pw.y = pk2(s[2 * u][2], s[2 * u][3]); pw.z = pk2(s[2 * u + 1][0], s[2 * u + 1][1]); pw.w = pk2(s[2 * u + 1][2], s[2 * u + 1][3]);
                const bf16x8 pb = __builtin_bit_cast(bf16x8, pw);
                __builtin_amdgcn_s_setprio(1);
#pragma unroll
                for (int dp = 0; dp < 4; ++dp) { const u32x4 rw = vA[u * 4 + dp];
                    Os[2 * dp] = MFMA16(fp8_frag(rw.x, rw.y), pb, Os[2 * dp]); Os[2 * dp + 1] = MFMA16(fp8_frag(rw.z, rw.w), pb, Os[2 * dp + 1]); }
                __builtin_amdgcn_s_setprio(0);
            }
            { const unsigned char* Vp = VSLb + (size_t)jn * 8192 + lo16;
#pragma unroll
                for (int i = 0; i < 8; ++i) vA[i] = *(const u32x4*)(Vp + i * 1024); }
            if (lastb) {
                l += __shfl_xor(l, 16); l += __shfl_xor(l, 32);
                if (n16 < 4) { LAS bf16_t* op = OSB + (qi * 4 + r16) * 136 + 4 * kq;
#pragma unroll
                    for (int dt = 0; dt < 8; ++dt) { u32x2 w; w.x = pk2(Os[dt].x, Os[dt].y); w.y = pk2(Os[dt].z, Os[dt].w); *(LAS u32x2*)(op + 16 * dt) = w; }
                    if (kq == 0) LR[qi * 4 + r16] = l; }
#pragma unroll
                for (int dt = 0; dt < 8; ++dt) Os[dt] = (f32x4){0.f, 0.f, 0.f, 0.f};
                l = 0.f;
            }
            si = sn; qi = qn; jcur = jn;
        }
    } else {
        const unsigned zz = (unsigned)opaque(0);
#pragma unroll
        for (int i = 0; i < 9; ++i) { const int idx = lane + 64 * i; if (idx < 32 * 136 / 8) *(LAS u32x4*)(OSB + 8 * idx) = (u32x4){zz, zz, zz, zz}; }
        if (lane < 32) LR[lane] = 0.f;
    }
    LDS_WAIT();
    {
        bf16x8 q[8];
        const bf16_t* qp = QR + tok * 1024 + (4 * g + r) * 128 + 8 * h;
#pragma unroll
        for (int ks = 0; ks < 8; ++ks) q[ks] = *(const bf16x8*)(qp + 16 * ks);
        const float* glp = GL + tok * 24 + (4 * g + r) * 3;
        const float g1 = sigmoidf_(glp[1]), g2 = sigmoidf_(glp[2]);
        f32x16 O[4];
#pragma unroll
        for (int dt = 0; dt < 4; ++dt)
#pragma unroll
            for (int i = 0; i < 16; ++i) O[dt][i] = 0.f;
        {
            const int lo_key = t0 - 511 > 0 ? t0 - 511 : 0; const int tlo = lo_key >> 5, thi = (t0 + 7) >> 5;
            float l = attn_pass2<false, true>(KW, VWT, tlo, thi, q, tq - 512, tq, 1.f, 1.f, O, nullptr, nullptr, n, h, lofs);
            l += __shfl_xor(l, 32);
            const float sc = g2 / l;
#pragma unroll
            for (int dt = 0; dt < 4; ++dt)
#pragma unroll
                for (int i = 0; i < 16; ++i) O[dt][i] *= sc;
        }
        {
            const int a_lo = 0, a_hi = cur >= 2 ? 1 : 2 * cur + 1, b_lo = 2 * cur - 2, b_hi = 2 * cur + 1; const bool two = cur >= 2;
            float lf = attn_pass1(KS32, a_lo, a_hi, q, -1, tq, lofs, h);
            if (two) lf += attn_pass1(KS32, b_lo, b_hi, q, -1, tq, lofs, h);
            const float lt = lf + LR[n];
            const float sc = g1 / lt;
            (void)attn_pass2<false, true>(KS32, VS32, a_lo, a_hi, q, -1, tq, 1.f, sc, O, nullptr, nullptr, n, h, lofs);
            if (two) (void)attn_pass2<false, true>(KS32, VS32, b_lo, b_hi, q, -1, tq, 1.f, sc, O, nullptr, nullptr, n, h, lofs);
            float ss = 0.f;
#pragma unroll
            for (int dt = 0; dt < 4; ++dt)
#pragma unroll
                for (int i4 = 0; i4 < 4; ++i4) { const int eo = n * 136 + 32 * dt + 8 * i4 + 4 * h;
                    const u32x2 pc = *(const LAS u32x2*)(OCB + eo), pb2 = *(const LAS u32x2*)(OSB + eo);
                    const float cv[4] = {__uint_as_float(pc.x << 16), __uint_as_float(pc.x & 0xffff0000u), __uint_as_float(pc.y << 16), __uint_as_float(pc.y & 0xffff0000u)};
                    const float bv[4] = {__uint_as_float(pb2.x << 16), __uint_as_float(pb2.x & 0xffff0000u), __uint_as_float(pb2.y << 16), __uint_as_float(pb2.y & 0xffff0000u)};
#pragma unroll
                    for (int e = 0; e < 4; ++e) { const float v = O[dt][4 * i4 + e] + cv[e] + bv[e] * sc; O[dt][4 * i4 + e] = v; ss += v * v; } }
            ss += __shfl_xor(ss, 32);
            const float rstd = rsqrtf(ss * (1.f / 128.f) + EPS);
            LDS_WAIT();
#pragma unroll
            for (int dt = 0; dt < 4; ++dt)
#pragma unroll
                for (int i4 = 0; i4 < 4; ++i4) { u32x2 w; w.x = pk2(O[dt][4 * i4] * rstd, O[dt][4 * i4 + 1] * rstd); w.y = pk2(O[dt][4 * i4 + 2] * rstd, O[dt][4 * i4 + 3] * rstd);
                    *(LAS u32x2*)(OCB + n * 136 + 32 * dt + 8 * i4 + 4 * h) = w; }
        }
        LDS_WAIT();
#pragma unroll 2
        for (int q8 = 0; q8 < 8; ++q8) { const int e = lane * 8, rr = e >> 7, d = e & 127;
            const u32x4 w = *(const LAS u32x4*)(OCB + (q8 * 4 + rr) * 136 + d);
            *(u32x4*)(Y + (tok0 + q8) * D + 1024 + 4 * g * 128 + e) = w; }
    }
    LDS_WAIT();
}

__global__ void __launch_bounds__(512, 2) hymba_fwd(Args a) {
    extern __shared__ __attribute__((aligned(16))) unsigned char lds_raw[];
    LAS unsigned char* lds = (LAS unsigned char*)lds_raw;
    cg::grid_group grid = cg::this_grid();
    const int tid0 = threadIdx.x, wave = __builtin_amdgcn_readfirstlane(tid0 >> 6), G = gridDim.x;
    const int gw = blockIdx.x * 8 + wave, NGW = G * 8;
    unsigned char* ws = a.ws;
    float* ADA = (float*)(ws + WS_ADA);
    bf16_t* XN = (bf16_t*)(ws + WS_XN);
    volatile LAS unsigned* bst = (volatile LAS unsigned*)(lds + 8 * WAVE_LDS);
    if (tid0 < 16) bst[tid0] = 0u;
    __syncthreads();
    if (blockIdx.x == 0) { unsigned* cw = (unsigned*)(ws + WS_BAR); for (int i = tid0; i < 4096; i += 512) __hip_atomic_store(cw + i, 0u, __ATOMIC_RELAXED, __HIP_MEMORY_SCOPE_AGENT); }
    grid.sync();
    const XcdBarrier xbar = xcd_barrier_post((unsigned*)(ws + WS_BAR), bst);

    { const int tid = opaque(tid0); p0_prologue(a, lds, tid, tid & 63, wave, G); }
    xcd_barrier(xbar);
    { const int lane = opaque(tid0) & 63;
      norm_mod_rows(a.in[I_X], a.in[I_NMIX], ADA, 0, 1, XN, gw, NGW, lane);
      bias13_rows((const bf16_t*)(ws + WS_W13), ADA, (float*)(ws + WS_BIAS13), gw, NGW, lane);
      float* sq = (float*)(ws + WS_SUMSQ); for (int i = blockIdx.x * 512 + opaque(tid0); i < T; i += G * 512) sq[i] = 0.f; }
    xcd_barrier(xbar);
    {
        pg8::Gemm g{XN, (const bf16_t*)(ws + WS_WIN), T, INWP, D, D}; pg8::StaticOrder so; so.init(T, INWP, G, (int)blockIdx.x, 4);
        pg8::EpiProj E{(bf16_t*)(ws + WS_CONVIN), (bf16_t*)(ws + WS_KV6), (float*)(ws + WS_GL)};
        pg8::gemm_phase<pg8::EpiProj, pg8::StaticOrder, true>(lds, g, so, E);
    }
    xcd_barrier(xbar);
    {
        const int NGEMM = (G >= 64) ? 32 : 0;
        if ((int)blockIdx.x < NGEMM) {
            const int kv = blockIdx.x >> 4;
            pg8::Gemm g{(const bf16_t*)(ws + WS_KV6) + (size_t)kv * 4 * S * 128, (const bf16_t*)(ws + (kv ? WS_CW1V : WS_CW1K)), 4096, 256, 4096, 2048};
            pg8::OneUnit ou{(int)(blockIdx.x & 15)};
            pg8::EpiHid E{(float*)(ws + WS_HID) + (size_t)kv * 4096 * 256, (const float*)(ws + WS_CB1) + kv * 256};
            pg8::gemm_phase<pg8::EpiHid, pg8::OneUnit, false>(lds, g, ou, E);
        } else {
            const int ew = (blockIdx.x - NGEMM) * 8 + wave, NEW = (G - NGEMM) * 8, lane = opaque(tid0) & 63;
            LAS unsigned char* wl = lds + wave * WAVE_LDS;
            conv_range(a, (const bf16_t*)(ws + WS_CONVIN), (bf16_t*)(ws + WS_Y), (int)((long)ew * T / NEW), (int)((long)(ew + 1) * T / NEW), lane);
            for (int it = ew; it < T; it += NEW) normrope_item(a, ws, it, lane);
            for (int it = ew; it < 3072; it += NEW) vtrans_item(ws, it >> 10, it & 1023, wl, lane);
        }
        if (NGEMM == 0) {
            for (int u = blockIdx.x; u < 32; u += G) { const int kv = u >> 4;
                pg8::Gemm g{(const bf16_t*)(ws + WS_KV6) + (size_t)kv * 4 * S * 128, (const bf16_t*)(ws + (kv ? WS_CW1V : WS_CW1K)), 4096, 256, 4096, 2048};
                pg8::OneUnit ou{u & 15}; pg8::EpiHid E{(float*)(ws + WS_HID) + (size_t)kv * 4096 * 256, (const float*)(ws + WS_CB1) + kv * 256};
                __syncthreads();
                pg8::gemm_phase<pg8::EpiHid, pg8::OneUnit, false>(lds, g, ou, E); }
        }
    }
    xcd_barrier(xbar);
    cmp2_phase(a, ws, lds, opaque(tid0), wave, G);
    xcd_barrier(xbar);
    {
        LAS unsigned char* wl = lds + wave * WAVE_LDS;
        unsigned* heads = (unsigned*)(ws + WS_BAR) + 3584;
        const int bg0 = (int)(blockIdx.x & 3);
#pragma unroll 1
        for (int sidx = 0; sidx < 4; ++sidx) {
            const int bg = (bg0 + sidx) & 3;
#pragma unroll 1
            for (;;) {
                int it = 0; if ((tid0 & 63) == 0) it = (int)atomicAdd(heads + 64 * bg, 1u); it = __builtin_amdgcn_readfirstlane(it);
                if (it >= 2048) break;
                attn_item(a, ws, wl, bg, 2047 - it, opaque(tid0) & 63);
            }
        }
    }
    xcd_barrier(xbar);
    {
        pg8::Gemm g{(const bf16_t*)(ws + WS_Y), (const bf16_t*)(ws + WS_WOUT), T, D, D, D}; pg8::StaticOrder so; so.init(T, D, G, (int)blockIdx.x, 4);
        pg8::EpiRes2 E{a.in[I_X], (bf16_t*)(ws + WS_X1B), ADA + 2 * 2048, a.in[I_NFFN], ADA + 4 * 2048, XN, (float*)(ws + WS_SUMSQ)};
        pg8::gemm_phase<pg8::EpiRes2, pg8::StaticOrder, true>(lds, g, so, E);
    }
    xcd_barrier(xbar);
    {
        pg8::Gemm g{XN, (const bf16_t*)(ws + WS_W13), T, 2 * DFF, D, D}; pg8::StaticOrder so; so.init(T, 2 * DFF, G, (int)blockIdx.x, 4);
        pg8::EpiSwiGLU E{(bf16_t*)(ws + WS_ACT), (const float*)(ws + WS_SUMSQ), (const float*)(ws + WS_BIAS13)};
        pg8::gemm_phase<pg8::EpiSwiGLU, pg8::StaticOrder, true>(lds, g, so, E);
    }
    xcd_barrier(xbar);
    {
        pg8::Gemm g{(const bf16_t*)(ws + WS_ACT), (const bf16_t*)(ws + WS_W2), T, D, DFF, DFF}; pg8::StaticOrder so; so.init(T, D, G, (int)blockIdx.x, 2);
        pg8::EpiRes E{(const bf16_t*)(ws + WS_X1B), a.out, ADA + 5 * 2048};
        pg8::gemm_phase<pg8::EpiRes, pg8::StaticOrder, true>(lds, g, so, E);
    }
}

extern "C" void kernel_launch(void* const* d_in, const int* in_sizes, int n_in, void* d_out, int out_size, void* d_ws, size_t ws_size, hipStream_t stream) {
    static int grid = 0;
    if (grid == 0) {
        if (n_in != 25 || out_size != T * D || ws_size < WS_END) { fprintf(stderr, "kernel_launch: unexpected shapes (n_in %d, out %d, ws %zu)\n", n_in, out_size, ws_size); grid = -1; return; }
        int dev = 0, cus = 0, per_cu = 0;
        hipGetDevice(&dev); hipDeviceGetAttribute(&cus, hipDeviceAttributeMultiprocessorCount, dev);
        hipFuncSetAttribute((const void*)hymba_fwd, hipFuncAttributeMaxDynamicSharedMemorySize, LDS_BYTES);
        if (hipOccupancyMaxActiveBlocksPerMultiprocessor(&per_cu, (const void*)hymba_fwd, 512, LDS_BYTES) != hipSuccess || per_cu < 1) per_cu = 1;
        (void)hipGetLastError();
        if (per_cu > 1) per_cu = 1;
        grid = cus * per_cu;
    }
    if (grid < 0) return;
    Args a{};
    for (int i = 0; i < 25; ++i) a.in[i] = (const float*)d_in[i];
    a.out = (float*)d_out; a.ws = (unsigned char*)d_ws;
    void* args[] = {&a};
    hipError_t e = hipLaunchCooperativeKernel((const void*)hymba_fwd, dim3(grid), dim3(512), args, LDS_BYTES, stream);
    if (e != hipSuccess) fprintf(stderr, "cooperative launch failed: %s (grid %d)\n", hipGetErrorString(e), grid);
}
```

```cpp
#include <hip/hip_runtime.h>
#include <hip/hip_cooperative_groups.h>
#include <cstdio>
#include <cstdint>
namespace cg = cooperative_groups;

#define DI __device__ __forceinline__
#define LAS __attribute__((address_space(3)))
typedef unsigned short bf16_t;
typedef short bf16x8 __attribute__((ext_vector_type(8)));
typedef float f32x2 __attribute__((ext_vector_type(2)));
typedef float f32x4 __attribute__((ext_vector_type(4)));
typedef float f32x16 __attribute__((ext_vector_type(16)));
typedef unsigned u32x2 __attribute__((ext_vector_type(2)));
typedef unsigned u32x4 __attribute__((ext_vector_type(4)));
typedef __bf16 bf16v2 __attribute__((ext_vector_type(2)));

constexpr int NB = 2, S = 16384, T = NB * S, D = 2048, CONVW = 1024, INW = 5656, INWP = 5888, DFF = 5632;
constexpr float EPS = 1e-6f;
constexpr size_t MiB = 1u << 20;
constexpr size_t WS_ADA = 0, WS_ROPE = 1 * MiB, WS_WIN = 17 * MiB, WS_WOUT = 40 * MiB, WS_W13 = 48 * MiB, WS_W2 = 92 * MiB,
                 WS_CW1K = 114 * MiB, WS_CW1V = 116 * MiB, WS_CB1 = 118 * MiB, WS_HID = 119 * MiB, WS_KCMP = 127 * MiB, WS_VCMPT = 128 * MiB,
                 WS_GL = 129 * MiB, WS_KV6 = 132 * MiB, WS_KSL = 230 * MiB, WS_KWN = 246 * MiB, WS_VSLT = 262 * MiB, WS_VWNT = 278 * MiB,
                 WS_QR = 294 * MiB, WS_CONVIN = 358 * MiB, WS_XN = 614 * MiB, WS_Y = 742 * MiB, WS_ACT = 230 * MiB, WS_QR8 = 870 * MiB, WS_KSL32 = 902 * MiB, WS_VSL32 = 918 * MiB, WS_X1B = 870 * MiB  , WS_END = 998 * MiB;
constexpr size_t WS_SUMSQ = WS_CB1 + 65536, WS_BIAS13 = WS_CB1 + 262144;
constexpr size_t WS_BAR = WS_CB1 + 524288;
constexpr int LDS_BYTES = 8 * 18048 + 64;
constexpr int WAVE_LDS = 18048;

DI unsigned pk2(float lo, float hi) { f32x2 v = {lo, hi}; bf16v2 b = __builtin_convertvector(v, bf16v2); return __builtin_bit_cast(unsigned, b); }
DI float bf2f(bf16_t v) { return __uint_as_float((unsigned)v << 16); }
DI float wsum64(float v) {
#pragma unroll
    for (int o = 1; o < 64; o <<= 1) v += __shfl_xor(v, o);
    return v;
}
DI float sigmoidf_(float x) { return __builtin_amdgcn_rcpf(1.f + __expf(-x)); }
#define LDS_WAIT() asm volatile("s_waitcnt lgkmcnt(0)" ::: "memory")
DI int opaque(int x) { asm volatile("" : "+v"(x)); return x; }

namespace pg8 {
constexpr int BM = 256, BK = 64, HALF = 128, HTB = HALF * BK * 2, STAGE_BYTES = 8 * HTB, NXCD = 8;
__host__ __device__ __forceinline__ int lds_byte(int r, int c) { const int st = (r >> 4) * 2 + (c >> 5), rr = r & 15, cc = c & 31, ob = rr * 64 + cc * 2; return st * 1024 + (ob ^ (((ob >> 9) & 1) << 5)); }
__host__ __device__ __forceinline__ void stage_rc(int b, int& R, int& C) { const int st = b / 1024, sb = b % 1024, swz = sb ^ (((sb >> 9) & 1) << 5); R = (st >> 1) * 16 + swz / 64; C = (st & 1) * 32 + (swz % 64) / 2; }
__host__ __device__ __forceinline__ int perm32(int rho) { const int n = rho >> 4, i = rho & 15; return 8 * (i >> 2) + 4 * n + (i & 3); }
struct Unit { int pm, pn; };
struct Gemm { const bf16_t* A; const bf16_t* Bt; int M, N, K, lda; };
struct StaticOrder {
    int nM, nN, nwg, G, c, WGM;
    __device__ void init(int M, int N, int G_, int c_, int wgm) { nM = M / BM; nN = N / BM; nwg = nM * nN; G = G_; c = c_; WGM = wgm; }
    __device__ bool next(int i, Unit& u) const {
        const long L = (long)i * G + c; if (L >= nwg) return false;
        int wgid = (int)L; { const int q = nwg / NXCD, r = nwg % NXCD, xcd = wgid % NXCD, off = wgid / NXCD; wgid = (xcd < r ? xcd * (q + 1) : r * (q + 1) + (xcd - r) * q) + off; }
        const int nig = WGM * nN, gid = wgid / nig, fm = gid * WGM, gsz = (nM - fm) < WGM ? (nM - fm) : WGM;
        u.pm = fm + ((wgid % nig) % gsz); u.pn = (wgid % nig) / gsz; return true;
    }
};
struct OneUnit { int pm; __device__ bool next(int i, Unit& u) const { if (i) return false; u.pm = pm; u.pn = 0; return true; } };

template <class Epi, class Sched, bool ALIGN_EPI>
DI void gemm_phase(LAS unsigned char* lds, const Gemm g, const Sched& S_, const Epi& E) {
    const int tid = opaque((int)threadIdx.x), wid = __builtin_amdgcn_readfirstlane(tid >> 6), lane = tid & 63, wr = wid >> 2, wc = wid & 3, fr = lane & 15, fq = lane >> 4;
    const int K = g.K, nt = K / BK, lda = g.lda;
    unsigned voffA[2], voffB[2];
#pragma unroll
    for (int i = 0; i < 2; ++i) { int R, C; stage_rc(tid * 16 + i * 8192, R, C); const int Rb = Epi::PERM ? ((R & ~31) + perm32(R & 31)) : R;
        voffA[i] = (unsigned)(R * lda + C) * 2u; voffB[i] = (unsigned)(Rb * K + C) * 2u; }
    const size_t kstep = (size_t)(BK * 2);
    const size_t hstepA = (size_t)HALF * lda * 2, hstepB = (size_t)HALF * K * 2;
    const size_t tstepA = 2 * hstepA, tstepB = 2 * hstepB;
    const unsigned ldsw = (unsigned)wid * 1024u;
    const int aoff = lds_byte(wr * 64 + fr, fq * 8), boff = lds_byte(wc * 32 + fr, fq * 8);
#define PG8_SA(b, h) (((b) * 2 + (h)) * HTB)
#define PG8_SB(b, h) ((4 + (b) * 2 + (h)) * HTB)
#define PG8_STAGE(bufoff, gbase, voff) do { _Pragma("unroll") for (int _i = 0; _i < 2; ++_i) \
        __builtin_amdgcn_global_load_lds((const unsigned*)((const char*)(gbase) + (voff)[_i]), (LAS unsigned*)(lds + (bufoff) + ldsw + _i * 8192), 16, 0, 0); } while (0)
#define PG8_LDA(dst, b, h) do { _Pragma("unroll") for (int m = 0; m < 4; ++m) _Pragma("unroll") for (int k = 0; k < 2; ++k) dst[m][k] = *(const LAS bf16x8*)(lds + PG8_SA(b, h) + aoff + m * 2048 + k * 1024); } while (0)
#define PG8_LDB(dst, b, h) do { _Pragma("unroll") for (int n = 0; n < 2; ++n) _Pragma("unroll") for (int k = 0; k < 2; ++k) dst[n][k] = *(const LAS bf16x8*)(lds + PG8_SB(b, h) + boff + n * 2048 + k * 1024); } while (0)
#define PG8_MMA(ai, bj, At, Bt) do { __builtin_amdgcn_s_setprio(1); _Pragma("unroll") for (int m = 0; m < 4; ++m) _Pragma("unroll") for (int n = 0; n < 2; ++n) _Pragma("unroll") for (int k = 0; k < 2; ++k) \
        acc[ai][bj][m][n] = __builtin_amdgcn_mfma_f32_16x16x32_bf16(Bt[n][k], At[m][k], acc[ai][bj][m][n], 0, 0, 0); __builtin_amdgcn_s_setprio(0); } while (0)
#define PG8_WAIT_V(n) asm volatile("s_waitcnt vmcnt(" #n ")" ::: "memory")
#define PG8_WAIT_L(n) asm volatile("s_waitcnt lgkmcnt(" #n ")" ::: "memory")
#define PG8_BAR __builtin_amdgcn_s_barrier()
#define PG8_SCHED __builtin_amdgcn_sched_barrier(0)
    Unit cur, nxt; int ui = 0;
    if (!S_.next(0, cur)) return;
    f32x4 acc[2][2][4][2];
#pragma unroll
    for (int a = 0; a < 2; ++a)
#pragma unroll
        for (int b = 0; b < 2; ++b)
#pragma unroll
            for (int m = 0; m < 4; ++m)
#pragma unroll
                for (int n = 0; n < 2; ++n) acc[a][b][m][n] = (f32x4){0.f, 0.f, 0.f, 0.f};
    bf16x8 At[4][2], B0[2][2], B1[2][2];
    const char* cA = (const char*)g.A + (size_t)cur.pm * tstepA; const char* cB = (const char*)g.Bt + (size_t)cur.pn * tstepB;
    PG8_STAGE(PG8_SB(0, 0), cB, voffB); PG8_STAGE(PG8_SB(0, 1), cB + hstepB, voffB); PG8_STAGE(PG8_SA(0, 0), cA, voffA); PG8_STAGE(PG8_SA(0, 1), cA + hstepA, voffA);
    if (wr == 1) PG8_BAR;
    PG8_WAIT_V(2); PG8_BAR;
    PG8_STAGE(PG8_SB(1, 0), cB + kstep, voffB); PG8_STAGE(PG8_SA(1, 0), cA + kstep, voffA); PG8_STAGE(PG8_SB(1, 1), cB + hstepB + kstep, voffB);
    PG8_WAIT_V(6); PG8_BAR;
    for (;;) {
        const bool has_next = S_.next(ui + 1, nxt);
        const char* nA = has_next ? (const char*)g.A + (size_t)nxt.pm * tstepA : cA; const char* nB = has_next ? (const char*)g.Bt + (size_t)nxt.pn * tstepB : cB;
        for (int t = 0; t < nt; t += 2) {
            const bool last = (t == nt - 2);
            const char* a1 = cA + (size_t)(t + 1) * kstep;
            const char* a2 = last ? nA : cA + (size_t)(t + 2) * kstep; const char* b2 = last ? nB : cB + (size_t)(t + 2) * kstep;
            const char* a3 = a2 + kstep; const char* b3 = b2 + kstep;
            PG8_LDB(B0, 0, 0); PG8_LDB(B1, 0, 1); PG8_SCHED; PG8_LDA(At, 0, 0); PG8_STAGE(PG8_SA(1, 1), a1 + hstepA, voffA);
            PG8_WAIT_V(8); PG8_WAIT_L(0); PG8_BAR; PG8_MMA(0, 0, At, B0); PG8_MMA(0, 1, At, B1); PG8_BAR; PG8_SCHED;
            PG8_LDA(At, 0, 1); PG8_STAGE(PG8_SB(0, 0), b2, voffB); PG8_STAGE(PG8_SB(0, 1), b2 + hstepB, voffB); PG8_STAGE(PG8_SA(0, 0), a2, voffA);
            PG8_WAIT_V(8); PG8_WAIT_L(0); PG8_BAR; PG8_MMA(1, 0, At, B0); PG8_MMA(1, 1, At, B1); PG8_BAR; PG8_SCHED;
            PG8_LDB(B0, 1, 0); PG8_LDB(B1, 1, 1); PG8_SCHED; PG8_LDA(At, 1, 0); PG8_STAGE(PG8_SA(0, 1), a2 + hstepA, voffA);
            PG8_WAIT_V(8); PG8_WAIT_L(0); PG8_BAR; PG8_MMA(0, 0, At, B0); PG8_MMA(0, 1, At, B1); PG8_BAR; PG8_SCHED;
            PG8_LDA(At, 1, 1); PG8_STAGE(PG8_SB(1, 0), b3, voffB); PG8_STAGE(PG8_SB(1, 1), b3 + hstepB, voffB); PG8_STAGE(PG8_SA(1, 0), a3, voffA);
            PG8_WAIT_V(8); PG8_WAIT_L(0); PG8_BAR; PG8_MMA(1, 0, At, B0); PG8_MMA(1, 1, At, B1); PG8_BAR; PG8_SCHED;
        }
        if constexpr (ALIGN_EPI) { if (wr == 0) PG8_BAR; }
        E(acc, cur, wr, wc, fr, fq);
        if (!has_next) break;
#pragma unroll
        for (int a = 0; a < 2; ++a)
#pragma unroll
            for (int b = 0; b < 2; ++b)
#pragma unroll
                for (int m = 0; m < 4; ++m)
#pragma unroll
                    for (int n = 0; n < 2; ++n) acc[a][b][m][n] = (f32x4){0.f, 0.f, 0.f, 0.f};
        cur = nxt; cA = nA; cB = nB; ++ui;
        if constexpr (ALIGN_EPI) { if (wr == 1) PG8_BAR; }
    }
    PG8_WAIT_V(0);
    if constexpr (!ALIGN_EPI) { if (wr == 0) PG8_BAR; }
    PG8_BAR;
#undef PG8_SA
#undef PG8_SB
#undef PG8_STAGE
#undef PG8_LDA
#undef PG8_LDB
#undef PG8_MMA
#undef PG8_WAIT_V
#undef PG8_WAIT_L
#undef PG8_BAR
#undef PG8_SCHED
}

struct EpiProj {
    static constexpr bool PERM = true;
    bf16_t* convin; bf16_t* kv6; float* gl;
    DI void operator()(const f32x4 (&acc)[2][2][4][2], const Unit& u, int wr, int wc, int fr, int fq) const {
        const int row0 = u.pm * BM + wr * 64 + fr;
#pragma unroll
        for (int ai = 0; ai < 2; ++ai)
#pragma unroll
            for (int m = 0; m < 4; ++m) {
                const int row = row0 + ai * HALF + m * 16;
#pragma unroll
                for (int bj = 0; bj < 2; ++bj) {
                    const f32x4 v0 = acc[ai][bj][m][0], v1 = acc[ai][bj][m][1];
                    u32x4 w; w.x = pk2(v0[0], v0[1]); w.y = pk2(v0[2], v0[3]); w.z = pk2(v1[0], v1[1]); w.w = pk2(v1[2], v1[3]);
                    if (u.pn < 16) {
                        *(u32x4*)(convin + (size_t)row * 4096 + u.pn * 256 + bj * HALF + wc * 32 + 8 * fq) = w;
                    } else if (u.pn < 22) {
                        const int ti = u.pn - 16, b = row >> 14, s = row & (S - 1);
                        *(u32x4*)(kv6 + ((size_t)((ti * 4 + b * 2 + bj)) * S + s) * 128 + wc * 32 + 8 * fq) = w;
                    } else if (bj == 0 && wc == 0 && fq < 3) {
                        *(f32x4*)(gl + (size_t)row * 24 + 8 * fq) = v0; *(f32x4*)(gl + (size_t)row * 24 + 8 * fq + 4) = v1;
                    }
                }
            }
    }
};
struct EpiHid {
    static constexpr bool PERM = true;
    float* hid; const float* bias;
    DI void operator()(const f32x4 (&acc)[2][2][4][2], const Unit& u, int wr, int wc, int fr, int fq) const {
        const int row0 = u.pm * BM + wr * 64 + fr;
#pragma unroll
        for (int bj = 0; bj < 2; ++bj) {
            const int col = bj * HALF + wc * 32 + 8 * fq;
            const f32x4 b0 = *(const f32x4*)(bias + col), b1 = *(const f32x4*)(bias + col + 4);
#pragma unroll
            for (int ai = 0; ai < 2; ++ai)
#pragma unroll
                for (int m = 0; m < 4; ++m) {
                    const int row = row0 + ai * HALF + m * 16;
                    f32x4 v0 = acc[ai][bj][m][0] + b0, v1 = acc[ai][bj][m][1] + b1;
#pragma unroll
                    for (int e = 0; e < 4; ++e) {
                        float x = v0[e]; float z = 0.7978845608f * (x + 0.044715f * x * x * x); v0[e] = x * __builtin_amdgcn_rcpf(1.f + __expf(-2.f * z));
                        x = v1[e]; z = 0.7978845608f * (x + 0.044715f * x * x * x); v1[e] = x * __builtin_amdgcn_rcpf(1.f + __expf(-2.f * z));
                    }
                    *(f32x4*)(hid + (size_t)row * 256 + col) = v0; *(f32x4*)(hid + (size_t)row * 256 + col + 4) = v1;
                }
        }
    }
};
struct EpiRes {
    static constexpr bool PERM = true;
    const bf16_t* base; float* out; const float* gate;
    DI void operator()(const f32x4 (&acc)[2][2][4][2], const Unit& u, int wr, int wc, int fr, int fq) const {
        const int row0 = u.pm * BM + wr * 64 + fr, col0 = u.pn * BM + wc * 32 + 8 * fq;
        const int b = (u.pm * BM) >> 14;
#pragma unroll
        for (int bj = 0; bj < 2; ++bj) {
            const int col = col0 + bj * HALF;
            const f32x4 g0 = *(const f32x4*)(gate + (size_t)b * 12288 + col), g1 = *(const f32x4*)(gate + (size_t)b * 12288 + col + 4);
#pragma unroll
            for (int ai = 0; ai < 2; ++ai)
#pragma unroll
                for (int m = 0; m < 4; ++m) {
                    const size_t off = (size_t)(row0 + ai * HALF + m * 16) * D + col;
                    const u32x4 bw = *(const u32x4*)(base + off);
                    const f32x4 b0 = {__uint_as_float(bw.x << 16), __uint_as_float(bw.x & 0xffff0000u), __uint_as_float(bw.y << 16), __uint_as_float(bw.y & 0xffff0000u)};
                    const f32x4 b1 = {__uint_as_float(bw.z << 16), __uint_as_float(bw.z & 0xffff0000u), __uint_as_float(bw.w << 16), __uint_as_float(bw.w & 0xffff0000u)};
                    *(f32x4*)(out + off) = b0 + g0 * acc[ai][bj][m][0]; *(f32x4*)(out + off + 4) = b1 + g1 * acc[ai][bj][m][1];
                }
        }
    }
};
struct EpiRes2 {
    static constexpr bool PERM = true;
    const float* base; bf16_t* out; const float* gate; const float* gain; const float* scl; bf16_t* xs; float* sumsq;
    DI void operator()(const f32x4 (&acc)[2][2][4][2], const Unit& u, int wr, int wc, int fr, int fq) const {
        const int row0 = u.pm * BM + wr * 64 + fr, col0 = u.pn * BM + wc * 32 + 8 * fq;
        const int b = (u.pm * BM) >> 14;
        float ss[2][4];
#pragma unroll
        for (int ai = 0; ai < 2; ++ai)
#pragma unroll
            for (int m = 0; m < 4; ++m) ss[ai][m] = 0.f;
#pragma unroll
        for (int bj = 0; bj < 2; ++bj) {
            const int col = col0 + bj * HALF;
            const f32x4 gv0 = *(const f32x4*)(gate + (size_t)b * 12288 + col), gv1 = *(const f32x4*)(gate + (size_t)b * 12288 + col + 4);
            const f32x4 gm0 = *(const f32x4*)(gain + col) * (*(const f32x4*)(scl + (size_t)b * 12288 + col) + 1.f), gm1 = *(const f32x4*)(gain + col + 4) * (*(const f32x4*)(scl + (size_t)b * 12288 + col + 4) + 1.f);
#pragma unroll
            for (int ai = 0; ai < 2; ++ai)
#pragma unroll
                for (int m = 0; m < 4; ++m) {
                    const size_t off = (size_t)(row0 + ai * HALF + m * 16) * D + col;
                    const f32x4 xa = *(const f32x4*)(base + off) + gv0 * acc[ai][bj][m][0], xb = *(const f32x4*)(base + off + 4) + gv1 * acc[ai][bj][m][1];
                    { u32x4 w1; w1.x = pk2(xa.x, xa.y); w1.y = pk2(xa.z, xa.w); w1.z = pk2(xb.x, xb.y); w1.w = pk2(xb.z, xb.w); *(u32x4*)(out + off) = w1; }
                    ss[ai][m] += ((xa.x * xa.x + xa.y * xa.y) + (xa.z * xa.z + xa.w * xa.w)) + ((xb.x * xb.x + xb.y * xb.y) + (xb.z * xb.z + xb.w * xb.w));
                    const f32x4 ma = xa * gm0, mb = xb * gm1; u32x4 w; w.x = pk2(ma.x, ma.y); w.y = pk2(ma.z, ma.w); w.z = pk2(mb.x, mb.y); w.w = pk2(mb.z, mb.w);
                    *(u32x4*)(xs + off) = w;
                }
        }
#pragma unroll
        for (int ai = 0; ai < 2; ++ai)
#pragma unroll
            for (int m = 0; m < 4; ++m) { float v = ss[ai][m]; v += __shfl_xor(v, 16); v += __shfl_xor(v, 32);
                if (fq == 0) atomicAdd(sumsq + row0 + ai * HALF + m * 16, v); }
    }
};
struct EpiSwiGLU {
    static constexpr bool PERM = true;
    bf16_t* act; const float* sumsq; const float* bias;
    DI void operator()(const f32x4 (&acc)[2][2][4][2], const Unit& u, int wr, int wc, int fr, int fq) const {
        const int row0 = u.pm * BM + wr * 64 + fr, col = u.pn * HALF + wc * 32 + 8 * fq;
        const int b = (u.pm * BM) >> 14;
        const float* bp = bias + (size_t)b * (2 * DFF) + u.pn * BM + wc * 32 + 8 * fq;
        const f32x4 ba0 = *(const f32x4*)bp, ba1 = *(const f32x4*)(bp + 4), bb0 = *(const f32x4*)(bp + HALF), bb1 = *(const f32x4*)(bp + HALF + 4);
#pragma unroll
        for (int ai = 0; ai < 2; ++ai)
#pragma unroll
            for (int m = 0; m < 4; ++m) {
                const int row = row0 + ai * HALF + m * 16;
                const float rstd = rsqrtf(sumsq[row] * (1.f / D) + EPS);
                float o[8];
#pragma unroll
                for (int n = 0; n < 2; ++n)
#pragma unroll
                    for (int e = 0; e < 4; ++e) { const float a = acc[ai][0][m][n][e] * rstd + (n ? ba1[e] : ba0[e]), bv = acc[ai][1][m][n][e] * rstd + (n ? bb1[e] : bb0[e]);
                        o[4 * n + e] = a * __builtin_amdgcn_rcpf(1.f + __expf(-a)) * bv; }
                u32x4 w; w.x = pk2(o[0], o[1]); w.y = pk2(o[2], o[3]); w.z = pk2(o[4], o[5]); w.w = pk2(o[6], o[7]);
                *(u32x4*)(act + (size_t)row * DFF + col) = w;
            }
    }
};
}

#define XB_TMO      128
#define XB_XCNT(j)  (256  + 64 * (j))
#define XB_XSUB(j)  (1280 + 64 * (j))
#define XB_XGEN(j)  (2304 + 64 * (j))
#define XB_TOP      3328
#define XB_TOPGEN   3392
#define XCD_BAR_WORDS 3456
#define XB_SPIN_CAP (1u << 18)

__device__ __forceinline__ unsigned xb_ld(unsigned* p)              { return __hip_atomic_load(p, __ATOMIC_RELAXED, __HIP_MEMORY_SCOPE_AGENT); }
__device__ __forceinline__ unsigned xb_add(unsigned* p, unsigned v) { return __hip_atomic_fetch_add(p, v, __ATOMIC_RELAXED, __HIP_MEMORY_SCOPE_AGENT); }
__device__ __forceinline__ unsigned xb_xcc_id() { return (unsigned)__builtin_amdgcn_s_getreg((3 << 11) | 20) & 0xFu; }
#define XB_SPIN(cond, bar) do { unsigned _sp = 0; while (cond) { __builtin_amdgcn_s_sleep(1); \
    if ((++_sp & 255u) == 0u) { if (xb_ld(&(bar)[XB_TMO])) break; if (_sp > XB_SPIN_CAP) { atomicAdd(&(bar)[XB_TMO], 1u); break; } } } } while (0)

struct XcdBarrier {
    unsigned* bar; unsigned x;
    volatile LAS unsigned* st;
};

__device__ __forceinline__ XcdBarrier xcd_barrier_post(unsigned* bar, volatile LAS unsigned* st) {
    XcdBarrier b; b.bar = bar; b.x = xb_xcc_id(); b.st = st;
    if (threadIdx.x == 0) (void)xb_add(&bar[XB_XCNT(b.x)], 1u);
    return b;
}
__device__ __forceinline__ void xcd_barrier_complete(unsigned* bar, unsigned x, unsigned& nloc, unsigned& nx) {
    const unsigned G = gridDim.x * gridDim.y * gridDim.z;
    unsigned sum, cnt, mine, sp = 0u;
    for (;;) {
        sum = 0u; cnt = 0u; mine = 0u;
#pragma unroll
        for (unsigned j = 0; j < 16; ++j) { const unsigned c = xb_ld(&bar[XB_XCNT(j)]); sum += c; cnt += (c > 0u) ? 1u : 0u; mine = (j == x) ? c : mine; }
        if (sum == G) break;
        __builtin_amdgcn_s_sleep(1);
        if ((++sp & 255u) == 0u) { if (xb_ld(&bar[XB_TMO])) break; if (sp > XB_SPIN_CAP) { atomicAdd(&bar[XB_TMO], 1u); break; } }
    }
    nloc = mine > 0u ? mine : 1u; nx = cnt > 0u ? cnt : 1u;
}

__device__ __forceinline__ void xcd_barrier(const XcdBarrier& b) {
    asm volatile("s_waitcnt vmcnt(0)" ::: "memory");
    __syncthreads();
    if (threadIdx.x == 0) {
        unsigned* bar = b.bar;
        __builtin_amdgcn_s_waitcnt(0);
        unsigned nloc = b.st[0], nx = b.st[1];
        if (nloc == 0u) { xcd_barrier_complete(bar, b.x, nloc, nx); b.st[0] = nloc; b.st[1] = nx; }
        const unsigned old = xb_add(&bar[XB_XSUB(b.x)], 1u);
        const unsigned gen = old / nloc;
        if (old + 1u == (gen + 1u) * nloc) {
            __builtin_amdgcn_fence(__ATOMIC_RELEASE, "agent");
            asm volatile("s_waitcnt vmcnt(0)" ::: "memory");
            const unsigned og = xb_add(&bar[XB_TOP], 1u);
            const unsigned tg = og / nx;
            if (og + 1u == (tg + 1u) * nx) xb_add(&bar[XB_TOPGEN], 1u);
            else XB_SPIN(xb_ld(&bar[XB_TOPGEN]) == tg, bar);
            __builtin_amdgcn_fence(__ATOMIC_ACQUIRE, "agent");
            xb_add(&bar[XB_XGEN(b.x)], 1u);
            asm volatile("s_waitcnt vmcnt(0)" ::: "memory");
        } else {
            XB_SPIN(xb_ld(&bar[XB_XGEN(b.x)]) == gen, bar);
            __builtin_amdgcn_fence(__ATOMIC_ACQUIRE, "agent");
            asm volatile("s_waitcnt vmcnt(0)" ::: "memory");
        }
    }
    __syncthreads();
}


struct Args { const float* in[25]; float* out; unsigned char* ws; };
enum { I_X = 0, I_C, I_POS, I_ADAW, I_ADAB, I_NMIX, I_NFFN, I_WIN, I_CONVW, I_PEK, I_KW1, I_KB1, I_KW2, I_PEV, I_VW1, I_VB1, I_VW2, I_QN, I_KN, I_ONC, I_ONA, I_WOUT, I_W1, I_W3, I_W2 };

DI void transpose_item(const float* W, int K, int N, bf16_t* WT, int mode, LAS float* scr, int item, int lane, const float* kscA = nullptr, const float* kscB = nullptr) {
    const int nblk = (N + 63) / 64, kb = item / nblk, nb = item % nblk, k0 = 64 * kb, n0 = 64 * nb;
    const int nn = n0 + lane; const bool okc = nn < N;
    const float* wp = W + (size_t)k0 * N + (okc ? nn : 0);
#pragma unroll 16
    for (int i = 0; i < 64; ++i) { const int kg = k0 + i; float v = wp[(size_t)i * N]; if (kscA) v *= (kg < 1024 ? kscA[kg] : kscB[kg - 1024]); scr[i * 65 + lane] = okc ? v : 0.f; }
    LDS_WAIT();
    const int c = lane & 7;
#pragma unroll
    for (int j = 0; j < 8; ++j) { const int n = (lane >> 3) + 8 * j; const LAS float* sp = scr + (8 * c) * 65 + n;
        u32x4 o; o.x = pk2(sp[0 * 65], sp[1 * 65]); o.y = pk2(sp[2 * 65], sp[3 * 65]); o.z = pk2(sp[4 * 65], sp[5 * 65]); o.w = pk2(sp[6 * 65], sp[7 * 65]);
        const int ng = n0 + n;
        if (ng < N) { const int row = mode == 0 ? ng : (256 * (ng >> 7) + (ng & 127) + (mode == 2 ? 128 : 0)); *(u32x4*)(WT + (size_t)row * K + k0 + 8 * c) = o; } }
    LDS_WAIT();
}

DI void p0_prologue(const Args& a, LAS unsigned char* lds, int tid, int lane, int wave, int G) {
    unsigned char* ws = a.ws;
    const int gw = blockIdx.x * 8 + wave, NGW = G * 8;
    float* ADA = (float*)(ws + WS_ADA); float* CB1 = (float*)(ws + WS_CB1);
    LAS float* red = (LAS float*)lds;
    for (int task = blockIdx.x; task < 100; task += G) {
        const float *W, *v0, *v1, *bias; float *o0, *o1; int K, N, col0; bool dosilu;
        if (task < 96) { W = a.in[I_ADAW]; K = 2048; N = 12288; col0 = task * 128; v0 = a.in[I_C]; v1 = a.in[I_C] + 2048; dosilu = true; bias = a.in[I_ADAB] + col0; o0 = ADA + col0; o1 = ADA + 12288 + col0; }
        else { const int kv = (task - 96) >> 1, cgp = (task - 96) & 1; W = a.in[kv ? I_VW1 : I_KW1]; K = 4096; N = 256; col0 = cgp * 128; v0 = a.in[kv ? I_PEV : I_PEK]; v1 = nullptr; dosilu = false;
            bias = a.in[kv ? I_VB1 : I_KB1] + col0; o0 = CB1 + kv * 256 + col0; o1 = nullptr; }
        LAS float* vec = (LAS float*)(lds + 8192);
        for (int i = tid; i < K; i += 512) { float c0 = v0[i]; if (dosilu) c0 = c0 * __builtin_amdgcn_rcpf(1.f + __expf(-c0)); vec[i] = c0;
            float c1 = 0.f; if (v1) { c1 = v1[i]; c1 = c1 * __builtin_amdgcn_rcpf(1.f + __expf(-c1)); } vec[4096 + i] = c1; }
        __syncthreads();
        const int kper = K / 8; f32x2 a0 = {0.f, 0.f}, a1 = {0.f, 0.f};
        const float* wp = W + (size_t)(wave * kper) * N + col0 + 2 * lane;
        const LAS float* vp = vec + wave * kper;
#pragma unroll 16
        for (int k = 0; k < kper; ++k) { const f32x2 w = *(const f32x2*)(wp + (size_t)k * N); a0 += w * vp[k]; a1 += w * vp[4096 + k]; }
        *(LAS f32x2*)(red + (wave * 2 + 0) * 128 + 2 * lane) = a0; *(LAS f32x2*)(red + (wave * 2 + 1) * 128 + 2 * lane) = a1;
        __syncthreads();
        if (wave < 2) { float s0 = 0.f, s1 = 0.f;
#pragma unroll
            for (int w = 0; w < 8; ++w) { s0 += red[(w * 2 + wave) * 128 + lane]; s1 += red[(w * 2 + wave) * 128 + 64 + lane]; }
            float* op = wave ? o1 : o0; if (op) { op[lane] = s0 + bias[lane]; op[64 + lane] = s1 + bias[64 + lane]; } }
        __syncthreads();
    }
    { float* RC = (float*)(ws + WS_ROPE); float* RS = RC + (size_t)T * 64; const int* pos = (const int*)a.in[I_POS];
      for (int idx = gw * 64 + lane; idx < T * 64; idx += NGW * 64) { const int t = idx >> 6, i = idx & 63;
          const float inv = 1.0f / exp2f((float)i * (13.287712379549449f / 64.f)); const float ang = (float)pos[t] * inv;
          const double rev = (double)ang * 0.15915494309189535; const float fr = (float)(rev - __builtin_rint(rev));
          RC[idx] = __builtin_amdgcn_cosf(fr); RS[idx] = __builtin_amdgcn_sinf(fr); } }
    { LAS float* scr = (LAS float*)(lds + wave * WAVE_LDS);
      bf16_t* WinT = (bf16_t*)(ws + WS_WIN); bf16_t* WoutT = (bf16_t*)(ws + WS_WOUT); bf16_t* W13T = (bf16_t*)(ws + WS_W13); bf16_t* W2T = (bf16_t*)(ws + WS_W2);
      bf16_t* CW1K = (bf16_t*)(ws + WS_CW1K); bf16_t* CW1V = (bf16_t*)(ws + WS_CW1V);
      constexpr int I_IN = 32 * 89, I_O = 32 * 32, I_F1 = 32 * 88, I_F2 = 88 * 32, I_C1 = 64 * 4;
      constexpr int NITEMS = I_IN + I_O + 2 * I_F1 + I_F2 + 2 * I_C1;
      unsigned* qctr = (unsigned*)(ws + WS_BAR) + 3520;
      for (;;) { int it = 0; if (lane == 0) it = (int)atomicAdd(qctr, 1u); it = __builtin_amdgcn_readfirstlane(it); if (it >= NITEMS) break; int r = it;
          if (r < I_IN) { transpose_item(a.in[I_WIN], D, INW, WinT, 0, scr, r, lane); continue; } r -= I_IN;
          if (r < I_O) { transpose_item(a.in[I_WOUT], D, D, WoutT, 0, scr, r, lane, a.in[I_ONC], a.in[I_ONA]); continue; } r -= I_O;
          if (r < I_F1) { transpose_item(a.in[I_W1], D, DFF, W13T, 1, scr, r, lane); continue; } r -= I_F1;
          if (r < I_F1) { transpose_item(a.in[I_W3], D, DFF, W13T, 2, scr, r, lane); continue; } r -= I_F1;
          if (r < I_F2) { transpose_item(a.in[I_W2], DFF, D, W2T, 0, scr, r, lane); continue; } r -= I_F2;
          if (r < I_C1) { transpose_item(a.in[I_KW1], 4096, 256, CW1K, 0, scr, r, lane); continue; } r -= I_C1;
          transpose_item(a.in[I_VW1], 4096, 256, CW1V, 0, scr, r, lane); }
      u32x4* z = (u32x4*)(WinT + (size_t)INW * D); const int nz = (INWP - INW) * D / 8;
      for (int i = blockIdx.x * 512 + tid; i < nz; i += G * 512) z[i] = (u32x4){0u, 0u, 0u, 0u}; }
}

DI void norm_mod_rows(const float* src, const float* gain, const float* ada, int shi, int sci, bf16_t* dst, int gw, int NGW, int lane) {
    f32x4 gm[8], sh[8]; int bprev = -1;
    for (int m = gw; m < T; m += NGW) {
        const int b = m >> 14;
        if (b != bprev) { bprev = b;
#pragma unroll
            for (int j = 0; j < 8; ++j) { const int col = 4 * lane + 256 * j;
                gm[j] = *(const f32x4*)(gain + col) * (*(const f32x4*)(ada + b * 12288 + sci * 2048 + col) + 1.f); sh[j] = *(const f32x4*)(ada + b * 12288 + shi * 2048 + col); } }
        const f32x4* xr = (const f32x4*)(src + (size_t)m * D) + lane;
        f32x4 v[8]; float s = 0.f;
#pragma unroll
        for (int j = 0; j < 8; ++j) { v[j] = xr[64 * j]; s += (v[j].x * v[j].x + v[j].y * v[j].y) + (v[j].z * v[j].z + v[j].w * v[j].w); }
        const float rstd = rsqrtf(wsum64(s) * (1.f / D) + EPS);
#pragma unroll
        for (int j = 0; j < 8; ++j) { const int col = 4 * lane + 256 * j;
            const f32x4 o = v[j] * rstd * gm[j] + sh[j];
            u32x2 w; w.x = pk2(o.x, o.y); w.y = pk2(o.z, o.w);
            *(u32x2*)(dst + (size_t)m * D + col) = w; }
    }
}

DI void bias13_rows(const bf16_t* W13T, const float* ada, float* bias13, int gw, int NGW, int lane) {
    for (int n = gw; n < 2 * DFF; n += NGW) {
        float s0 = 0.f, s1 = 0.f;
#pragma unroll
        for (int j = 0; j < 4; ++j) { const int k = 8 * (lane + 64 * j); const u32x4 w = *(const u32x4*)(W13T + (size_t)n * D + k);
#pragma unroll
            for (int e = 0; e < 4; ++e) { const float wa = __uint_as_float(w[e] << 16), wb = __uint_as_float(w[e] & 0xffff0000u);
                s0 += wa * ada[3 * 2048 + k + 2 * e] + wb * ada[3 * 2048 + k + 2 * e + 1];
                s1 += wa * ada[12288 + 3 * 2048 + k + 2 * e] + wb * ada[12288 + 3 * 2048 + k + 2 * e + 1]; } }
        s0 = wsum64(s0); s1 = wsum64(s1);
        if (lane == 0) { bias13[n] = s0; bias13[2 * DFF + n] = s1; }
    }
}

DI float dpp_x1(float v) { return __int_as_float(__builtin_amdgcn_update_dpp(0, __float_as_int(v), 0xB1, 0xF, 0xF, false)); }
DI float dpp_x2(float v) { return __int_as_float(__builtin_amdgcn_update_dpp(0, __float_as_int(v), 0x4E, 0xF, 0xF, false)); }
DI float dpp_r4(float v) { return __int_as_float(__builtin_amdgcn_update_dpp(0, __float_as_int(v), 0x124, 0xF, 0xF, false)); }
DI float dpp_r8(float v) { return __int_as_float(__builtin_amdgcn_update_dpp(0, __float_as_int(v), 0x128, 0xF, 0xF, false)); }
DI float row16_sum(float v) { v += dpp_x1(v); v += dpp_x2(v); v += dpp_r4(v); v += dpp_r8(v); return v; }
DI void conv_range(const Args& a, const bf16_t* CIN, bf16_t* Y, int tb, int te, int lane) {
    const float* cw = a.in[I_CONVW];
#pragma unroll 1
    for (int c2 = 0; c2 < 2; ++c2) {
        const int ch0 = 512 * c2 + 8 * lane;
        float w0[8], w1[8], w2[8], u1[8], u2[8];
#pragma unroll
        for (int e = 0; e < 8; ++e) { w0[e] = cw[ch0 + e]; w1[e] = cw[1024 + ch0 + e]; w2[e] = cw[2048 + ch0 + e]; u1[e] = 0.f; u2[e] = 0.f; }
#pragma unroll
        for (int back = 2; back >= 1; --back) {
            if ((tb & (S - 1)) >= back) {
                const bf16_t* rp = CIN + (size_t)(tb - back) * 4096;
                const u32x4 cc = *(const u32x4*)(rp + 1024 + ch0), hh = *(const u32x4*)(rp + 2048 + ch0);
#pragma unroll
                for (int e = 0; e < 4; ++e) { const float ca = __uint_as_float(cc[e] << 16), cb_ = __uint_as_float(cc[e] & 0xffff0000u), ha = __uint_as_float(hh[e] << 16), hb = __uint_as_float(hh[e] & 0xffff0000u);
                    if (back == 2) { u2[2 * e] = ca * ha; u2[2 * e + 1] = cb_ * hb; } else { u1[2 * e] = ca * ha; u1[2 * e + 1] = cb_ * hb; } }
            }
        }
#pragma unroll 4
        for (int t = tb; t < te; ++t) {
            if ((t & (S - 1)) == 0) {
#pragma unroll
                for (int e = 0; e < 8; ++e) { u1[e] = 0.f; u2[e] = 0.f; } }
            const bf16_t* rp = CIN + (size_t)t * 4096;
            const u32x4 bb = *(const u32x4*)(rp + ch0), cc = *(const u32x4*)(rp + 1024 + ch0), hh = *(const u32x4*)(rp + 2048 + ch0);
            float y[8]; float ss = 0.f;
#pragma unroll
            for (int e = 0; e < 4; ++e) {
                const float ca = __uint_as_float(cc[e] << 16), cb_ = __uint_as_float(cc[e] & 0xffff0000u), ha = __uint_as_float(hh[e] << 16), hb = __uint_as_float(hh[e] & 0xffff0000u);
                const float ba = __uint_as_float(bb[e] << 16), bbb = __uint_as_float(bb[e] & 0xffff0000u);
                const float ua = ca * ha, ub = cb_ * hb;
                y[2 * e] = ba * (w0[2 * e] * u2[2 * e] + w1[2 * e] * u1[2 * e] + w2[2 * e] * ua);
                y[2 * e + 1] = bbb * (w0[2 * e + 1] * u2[2 * e + 1] + w1[2 * e + 1] * u1[2 * e + 1] + w2[2 * e + 1] * ub);
                u2[2 * e] = u1[2 * e]; u2[2 * e + 1] = u1[2 * e + 1]; u1[2 * e] = ua; u1[2 * e + 1] = ub;
                ss += y[2 * e] * y[2 * e] + y[2 * e + 1] * y[2 * e + 1];
            }
            ss = row16_sum(ss);
            const float rstd = rsqrtf(ss * (1.f / 128.f) + EPS);
            u32x4 w; w.x = pk2(y[0] * rstd, y[1] * rstd); w.y = pk2(y[2] * rstd, y[3] * rstd);
            w.z = pk2(y[4] * rstd, y[5] * rstd); w.w = pk2(y[6] * rstd, y[7] * rstd);
            *(u32x4*)(Y + (size_t)t * D + ch0) = w;
        }
    }
}
DI int perm_slc(int p) { const int q = p & 31; return (p & 32) | (((q >> 2) & 1) << 4) | ((q >> 3) << 2) | (q & 3); }
DI int perm_w16(int p) { return (p & ~15) | (p & 3) | ((p & 4) << 1) | ((p & 8) >> 1); }
DI size_t k32_off(int n, int d) { return (size_t)(n >> 5) * 4096 + (d >> 4) * 512 + ((((d & 15) >> 3) * 32) + (n & 31)) * 8 + (d & 7); }
DI size_t k16_off(int s, int d) { return (size_t)(s >> 6) * 8192 + ((s >> 4) & 3) * 2048 + (d >> 5) * 512 + (s & 15) * 32 + (d & 31); }
DI unsigned fp8x2(float a, float b) { return (unsigned)__builtin_amdgcn_cvt_pk_fp8_f32(a, b, 0, false) & 0xffffu; }
DI bf16x8 fp8_frag(unsigned w0, unsigned w1) {
    u32x4 o;
    o.x = __builtin_bit_cast(unsigned, __builtin_amdgcn_cvt_scalef32_pk_bf16_fp8(w0, 1.0f, false)); o.y = __builtin_bit_cast(unsigned, __builtin_amdgcn_cvt_scalef32_pk_bf16_fp8(w0, 1.0f, true));
    o.z = __builtin_bit_cast(unsigned, __builtin_amdgcn_cvt_scalef32_pk_bf16_fp8(w1, 1.0f, false)); o.w = __builtin_bit_cast(unsigned, __builtin_amdgcn_cvt_scalef32_pk_bf16_fp8(w1, 1.0f, true));
    return __builtin_bit_cast(bf16x8, o);
}
DI size_t k8_off(int s_, int d) { return (size_t)(s_ >> 6) * 8192 + (((s_ >> 4) & 3) * 2 + (d >> 6)) * 1024 + ((((d & 31) >> 3) * 16) + (s_ & 15)) * 16 + ((d >> 5) & 1) * 8 + (d & 7); }
constexpr float QSCALE = 0.08838834764831845f * 1.4426950408889634f;
DI void normrope_item(const Args& a, unsigned char* ws, int tok, int lane) {
    const bf16_t* CIN = (const bf16_t*)(ws + WS_CONVIN); const bf16_t* KV6 = (const bf16_t*)(ws + WS_KV6);
    const int b = tok >> 14, s = tok & (S - 1), hsub = lane >> 4, l16 = lane & 15, d0 = 8 * l16;
    const float* RC = (const float*)(ws + WS_ROPE) + (size_t)tok * 64 + (d0 & 63); const float* RS = RC + (size_t)T * 64;
    const f32x4 c0 = *(const f32x4*)RC, c1 = *(const f32x4*)(RC + 4), s0 = *(const f32x4*)RS, s1 = *(const f32x4*)(RS + 4);
    const float cs[8] = {c0.x, c0.y, c0.z, c0.w, c1.x, c1.y, c1.z, c1.w};
    const float sgn = l16 < 8 ? -1.f : 1.f;
    const float sn[8] = {s0.x * sgn, s0.y * sgn, s0.z * sgn, s0.w * sgn, s1.x * sgn, s1.y * sgn, s1.z * sgn, s1.w * sgn};
#pragma unroll
    for (int p = 0; p < 3; ++p) {
        const bf16_t* src; const float* gain; float scale = 1.f; int kind;
        int head;
        if (p < 2) { head = 4 * p + hsub; kind = 0; src = CIN + (size_t)tok * 4096 + 3072 + head * 128 + d0; gain = a.in[I_QN]; scale = QSCALE; }
        else if (hsub < 2) { head = hsub; kind = 1; src = KV6 + ((size_t)(2 * 4 + b * 2 + head) * S + s) * 128 + d0; gain = a.in[I_KN] + 128; }
        else { head = hsub - 2; kind = 2; src = KV6 + ((size_t)(4 * 4 + b * 2 + head) * S + s) * 128 + d0; gain = a.in[I_KN] + 256; }
        const u32x4 raw = *(const u32x4*)src;
        const f32x4 g0 = *(const f32x4*)(gain + d0), g1 = *(const f32x4*)(gain + d0 + 4);
        const float gg[8] = {g0.x, g0.y, g0.z, g0.w, g1.x, g1.y, g1.z, g1.w};
        float x[8]; float ss = 0.f;
#pragma unroll
        for (int e = 0; e < 4; ++e) { x[2 * e] = __uint_as_float(raw[e] << 16); x[2 * e + 1] = __uint_as_float(raw[e] & 0xffff0000u); ss += x[2 * e] * x[2 * e] + x[2 * e + 1] * x[2 * e + 1]; }
        const float rstd = rsqrtf(row16_sum(ss) * (1.f / 128.f) + EPS);
        float o[8];
#pragma unroll
        for (int e = 0; e < 8; ++e) { const float y = x[e] * rstd * gg[e]; const float pr = dpp_r8(y); o[e] = (y * cs[e] + pr * sn[e]) * scale; }
        u32x4 wb; wb.x = pk2(o[0], o[1]); wb.y = pk2(o[2], o[3]); wb.z = pk2(o[4], o[5]); wb.w = pk2(o[6], o[7]);
        u32x2 w8; w8.x = fp8x2(o[0], o[1]) | (fp8x2(o[2], o[3]) << 16); w8.y = fp8x2(o[4], o[5]) | (fp8x2(o[6], o[7]) << 16);
        if (kind == 0) {
            *(u32x4*)((bf16_t*)(ws + WS_QR) + (size_t)tok * 1024 + head * 128 + d0) = wb;
            *(u32x2*)((unsigned char*)(ws + WS_QR8) + (size_t)tok * 1024 + head * 128 + d0) = w8;
        } else if (kind == 1) {
            *(u32x2*)((unsigned char*)(ws + WS_KSL) + (size_t)(b * 2 + head) * S * 128 + k8_off(s, d0)) = w8;
            *(u32x4*)((bf16_t*)(ws + WS_KSL32) + (size_t)(b * 2 + head) * S * 128 + k32_off(s, d0)) = wb;
        } else {
            *(u32x4*)((bf16_t*)(ws + WS_KWN) + (size_t)(b * 2 + head) * S * 128 + k32_off(s, d0)) = wb;
        }
    }
}
DI void vtrans_item(unsigned char* ws, int mode, int item, LAS unsigned char* scr, int lane) {
    const bf16_t* KV6 = (const bf16_t*)(ws + WS_KV6);
    const int bg = item >> 8, blk = item & 255;
    const bf16_t* src = KV6 + ((size_t)((mode == 1 ? 5 : 3) * 4 + bg) * S + 64 * blk) * 128;
#pragma unroll 4
    for (int i = 0; i < 16; ++i) { const int c = lane + 64 * i, key = c >> 4, dc = c & 15;
        *(LAS u32x4*)(scr + key * 272 + dc * 16) = *(const u32x4*)(src + (size_t)key * 128 + dc * 8); }
    LDS_WAIT();
    if (mode) {
        bf16_t* dstb = (bf16_t*)(ws + (mode == 1 ? WS_VWNT : WS_VSL32)) + ((size_t)bg * 256 + blk) * 8192;
#pragma unroll 4
        for (int i = 0; i < 16; ++i) { const int c = lane + 64 * i, d = c >> 3, pc = c & 7;
            unsigned w[4];
#pragma unroll
            for (int e = 0; e < 4; ++e) { const int p0 = 8 * pc + 2 * e, k0 = perm_w16(p0), k1 = perm_w16(p0 + 1);
                const unsigned lo = *(const LAS bf16_t*)(scr + k0 * 272 + d * 2), hi = *(const LAS bf16_t*)(scr + k1 * 272 + d * 2); w[e] = lo | (hi << 16); }
            const size_t off = (size_t)(pc >> 2) * 4096 + ((pc >> 1) & 1) * 2048 + (d >> 5) * 512 + ((pc & 1) * 32 + (d & 31)) * 8;
            *(u32x4*)(dstb + off) = (u32x4){w[0], w[1], w[2], w[3]}; }
    } else {
        unsigned char* dstb = (unsigned char*)(ws + WS_VSLT) + ((size_t)bg * 256 + blk) * 8192;
#pragma unroll 4
        for (int i = 0; i < 16; ++i) { const int c = lane + 64 * i, d = c >> 3, pc = c & 7;
            unsigned w[4];
#pragma unroll
            for (int e = 0; e < 4; ++e) { const int p0 = 8 * pc + 2 * e, k0 = perm_slc(p0), k1 = perm_slc(p0 + 1);
                const float lo = bf2f(*(const LAS bf16_t*)(scr + k0 * 272 + d * 2)), hi = bf2f(*(const LAS bf16_t*)(scr + k1 * 272 + d * 2)); w[e] = fp8x2(lo, hi); }
            const size_t off = (size_t)((pc >> 2) * 4 + (d >> 5)) * 1024 + ((pc & 3) * 16 + (d & 15)) * 16 + ((d >> 4) & 1) * 8;
            *(u32x2*)(dstb + off) = (u32x2){w[0] | (w[1] << 16), w[2] | (w[3] << 16)}; }
    }
    LDS_WAIT();
}

DI void cmp2_row(const Args& a, const unsigned char* ws, const LAS float* w2s, int kv, int m, int lane) {
    const int bg = m >> 10, n = m & 1023;
    bf16_t* KC = (bf16_t*)(ws + WS_KCMP) + (size_t)bg * 131072; bf16_t* VT = (bf16_t*)(ws + WS_VCMPT) + (size_t)bg * 131072;
    float o1 = 0.f, o2 = 0.f;
    if (n < 1023) {
        const float* hid = (const float*)(ws + WS_HID) + ((size_t)kv * 4096 + m) * 256;
        const f32x4 hv4 = *(const f32x4*)(hid + 4 * lane);
#pragma unroll 4
        for (int h4 = 0; h4 < 64; ++h4) {
#pragma unroll
            for (int e = 0; e < 4; ++e) { const float hv = __int_as_float(__builtin_amdgcn_readlane(__float_as_int(hv4[e]), h4));
                o1 += hv * w2s[(4 * h4 + e) * 128 + lane]; o2 += hv * w2s[(4 * h4 + e) * 128 + 64 + lane]; } }
    }
    if (kv == 0) {
        float ss = wsum64(o1 * o1 + o2 * o2); const float rstd = rsqrtf(ss * (1.f / 128.f) + EPS);
        const float* gain = a.in[I_KN]; o1 *= rstd * gain[lane]; o2 *= rstd * gain[64 + lane];
        const int b = bg >> 1, tok = b * S + ((n < 1023) ? 16 * n + 31 : 0);
        const float* RC = (const float*)(ws + WS_ROPE) + (size_t)tok * 64; const float* RS = RC + (size_t)T * 64;
        const float c = RC[lane], sn = RS[lane];
        const float r1 = o1 * c - o2 * sn, r2 = o2 * c + o1 * sn;
        KC[k32_off(n, lane)] = (bf16_t)(pk2(r1, 0.f) & 0xffffu); KC[k32_off(n, 64 + lane)] = (bf16_t)(pk2(r2, 0.f) & 0xffffu);
    } else {
        const int pp = perm_w16(n & 15);
        const size_t base = (size_t)(n >> 5) * 4096 + ((n >> 4) & 1) * 2048 + ((pp >> 3) * 32 + (lane & 31)) * 8 + (pp & 7);
        VT[base + (lane >> 5) * 512] = (bf16_t)(pk2(o1, 0.f) & 0xffffu);
        VT[base + (2 + (lane >> 5)) * 512] = (bf16_t)(pk2(o2, 0.f) & 0xffffu);
    }
}
DI void cmp2_phase(const Args& a, const unsigned char* ws, LAS unsigned char* lds, int tid, int wave, int G) {
    const int lane = tid & 63;
    for (int kv = 0; kv < 2; ++kv) {
        if (G > 1 && (int)(blockIdx.x & 1) != kv) continue;
        const int nb = G > 1 ? (G + 1 - kv) / 2 : 1, bi = G > 1 ? (int)(blockIdx.x >> 1) : 0;
        const float* w2 = a.in[kv ? I_VW2 : I_KW2];
        __syncthreads();
        for (int i = tid; i < 8192; i += 512) *(LAS f32x4*)(lds + i * 16) = *(const f32x4*)(w2 + 4 * i);
        __syncthreads();
        for (int m = bi * 8 + wave; m < 4096; m += nb * 8) cmp2_row(a, ws, (const LAS float*)lds, kv, m, lane);
    }
    __syncthreads();
}

#define MFMA32(a, b, c) __builtin_amdgcn_mfma_f32_32x32x16_bf16((a), (b), (c), 0, 0, 0)
#define MFMA16(a, b, c) __builtin_amdgcn_mfma_f32_16x16x32_bf16((a), (b), (c), 0, 0, 0)
#define MFMA16F8(a, b, c) __builtin_amdgcn_mfma_f32_16x16x32_fp8_fp8((a), (b), (c), 0, 0, 0)
DI long mk64(unsigned lo, unsigned hi) { return (long)(((unsigned long long)hi << 32) | lo); }
DI void ld8(bf16x8 (&k)[8], const bf16_t* p) {
#pragma unroll
    for (int i = 0; i < 8; ++i) k[i] = *(const bf16x8*)(p + i * 512);
}
DI f32x16 qk32(const bf16x8 (&k)[8], const bf16x8 (&q)[8]) {
    f32x16 s;
#pragma unroll
    for (int i = 0; i < 16; ++i) s[i] = 0.f;
    __builtin_amdgcn_s_setprio(1);
#pragma unroll
    for (int ks = 0; ks < 8; ++ks) s = MFMA32(k[ks], q[ks], s);
    __builtin_amdgcn_s_setprio(0);
    return s;
}
DI void pass1_tile(const bf16_t* Kb, int tile, int tnext, bf16x8 (&kc)[8], bf16x8 (&kn)[8], const bf16x8 (&q)[8], int limlo, int limhi, int lofs, int h, float& l) {
    ld8(kn, Kb + (size_t)tnext * 4096 + lofs);
    const int key0 = 32 * tile; const f32x16 s = qk32(kc, q);
#pragma unroll
    for (int i = 0; i < 16; ++i) { const int key = key0 + 8 * (i >> 2) + 4 * h + (i & 3); l += (key <= limhi && key > limlo) ? __builtin_amdgcn_exp2f(s[i]) : 0.f; }
}
#define TM(i) ((i) + ((i) >= gap_at ? gap : 0))
DI float attn_pass1(const bf16_t* Kb, int tlo, int thi, const bf16x8 (&q)[8], int limlo, int limhi, int lofs, int h, int gap_at = 0x7fffffff, int gap = 0) {
    float l = 0.f; bf16x8 ka[8], kb[8]; ld8(ka, Kb + (size_t)TM(tlo) * 4096 + lofs);
    int tile = tlo;
#pragma unroll 1
    for (; tile < thi; tile += 2) {
        pass1_tile(Kb, TM(tile), TM(tile + 1), ka, kb, q, limlo, limhi, lofs, h, l);
        pass1_tile(Kb, TM(tile + 1), tile + 2 <= thi ? TM(tile + 2) : TM(tile + 1), kb, ka, q, limlo, limhi, lofs, h, l);
    }
    if (tile == thi) pass1_tile(Kb, TM(tile), TM(tile), ka, kb, q, limlo, limhi, lofs, h, l);
    return l + __shfl_xor(l, 32);
}
template <bool IMP, bool PV, bool SB = false>
DI void pass2_tile(const bf16_t* Kb, const bf16_t* VTb, int tile, int tnext, bf16x8 (&kc)[8], bf16x8 (&kn)[8], const bf16x8 (&q)[8], int limlo, int limhi, float inv, float gate,
                   f32x16 (&O)[4], LAS float* imp, LAS float* car, int n, int h, int lofs, float& l) {
    bf16x8 vf[8]; if (PV) ld8(vf, VTb + (size_t)tile * 4096 + lofs);
    if (!SB) ld8(kn, Kb + (size_t)tnext * 4096 + lofs);
    const int key0 = 32 * tile; const f32x16 s = qk32(kc, q);
    if (SB) ld8(kc, Kb + (size_t)tnext * 4096 + lofs);
    const float pscale = IMP ? inv : inv * gate, pgate = IMP ? gate : 1.f;
    float p[16];
#pragma unroll
    for (int i = 0; i < 16; ++i) { const int key = key0 + 8 * (i >> 2) + 4 * h + (i & 3); p[i] = (key <= limhi && key > limlo) ? __builtin_amdgcn_exp2f(s[i]) * pscale : 0.f; l += p[i]; }
    if (PV) {
#pragma unroll
        for (int u = 0; u < 2; ++u) {
            u32x4 pw; pw.x = pk2(p[8 * u] * pgate, p[8 * u + 1] * pgate); pw.y = pk2(p[8 * u + 2] * pgate, p[8 * u + 3] * pgate);
            pw.z = pk2(p[8 * u + 4] * pgate, p[8 * u + 5] * pgate); pw.w = pk2(p[8 * u + 6] * pgate, p[8 * u + 7] * pgate);
            const bf16x8 pb = __builtin_bit_cast(bf16x8, pw);
            __builtin_amdgcn_s_setprio(1);
#pragma unroll
            for (int dt = 0; dt < 4; ++dt) O[dt] = MFMA32(vf[4 * u + dt], pb, O[dt]);
            __builtin_amdgcn_s_setprio(0);
        }
    }
    if (IMP) {
#pragma unroll
        for (int i4 = 0; i4 < 4; ++i4) {
            float P4 = (p[4 * i4] + p[4 * i4 + 1]) + (p[4 * i4 + 2] + p[4 * i4 + 3]), pl = p[4 * i4 + 3];
            P4 += dpp_x1(P4); P4 += dpp_x2(P4); pl += dpp_x1(pl); pl += dpp_x2(pl);
            if ((n & 3) == 0) { const int j = 8 * tile + 2 * i4 + h, ql = n >> 2; imp[ql * 256 + j] = P4; if (j + 1 < 256) car[ql * 256 + j + 1] = pl; }
        }
    }
}
template <bool IMP, bool PV, bool SB = false>
DI float attn_pass2(const bf16_t* Kb, const bf16_t* VTb, int tlo, int thi, const bf16x8 (&q)[8], int limlo, int limhi, float inv, float gate,
                   f32x16 (&O)[4], LAS float* imp, LAS float* car, int n, int h, int lofs, int gap_at = 0x7fffffff, int gap = 0) {
    float l = 0.f;
    if constexpr (SB) {
        bf16x8 kc[8]; ld8(kc, Kb + (size_t)tlo * 4096 + lofs);
#pragma unroll 1
        for (int tile = tlo; tile <= thi; ++tile) pass2_tile<IMP, PV, true>(Kb, VTb, tile, tile < thi ? tile + 1 : tile, kc, kc, q, limlo, limhi, inv, gate, O, imp, car, n, h, lofs, l);
        return l;
    }
    bf16x8 ka[8], kb[8]; ld8(ka, Kb + (size_t)TM(tlo) * 4096 + lofs);
    int tile = tlo;
#pragma unroll 1
    for (; tile < thi; tile += 2) {
        pass2_tile<IMP, PV>(Kb, VTb, TM(tile), TM(tile + 1), ka, kb, q, limlo, limhi, inv, gate, O, imp, car, n, h, lofs, l);
        pass2_tile<IMP, PV>(Kb, VTb, TM(tile + 1), tile + 2 <= thi ? TM(tile + 2) : TM(tile + 1), kb, ka, q, limlo, limhi, inv, gate, O, imp, car, n, h, lofs, l);
    }
    if (tile == thi) pass2_tile<IMP, PV>(Kb, VTb, TM(tile), TM(tile), ka, kb, q, limlo, limhi, inv, gate, O, imp, car, n, h, lofs, l);
    return l;
}

DI void attn_item(const Args& a, const unsigned char* ws, LAS unsigned char* wl, int bg, int tile8, int lane) {
    const bf16_t* QR = (const bf16_t*)(ws + WS_QR); const float* GL = (const float*)(ws + WS_GL);
    const bf16_t* KC = (const bf16_t*)(ws + WS_KCMP) + (size_t)bg * 131072; const bf16_t* VCT = (const bf16_t*)(ws + WS_VCMPT) + (size_t)bg * 131072;
    const bf16_t* KW = (const bf16_t*)(ws + WS_KWN) + (size_t)bg * S * 128; const bf16_t* VWT = (const bf16_t*)(ws + WS_VWNT) + (size_t)bg * S * 128;
    const bf16_t* KS32 = (const bf16_t*)(ws + WS_KSL32) + (size_t)bg * S * 128; const bf16_t* VS32 = (const bf16_t*)(ws + WS_VSL32) + (size_t)bg * S * 128;
    const unsigned char* KSLb = (const unsigned char*)(ws + WS_KSL) + (size_t)bg * S * 128; const unsigned char* VSLb = (const unsigned char*)(ws + WS_VSLT) + (size_t)bg * S * 128;
    bf16_t* Y = (bf16_t*)(ws + WS_Y);
    LAS float* IMPL = (LAS float*)wl; LAS float* CARL = (LAS float*)(wl + 8192); LAS bf16_t* OCB = (LAS bf16_t*)wl; LAS bf16_t* OSB = (LAS bf16_t*)(wl + 8704); LAS int* SEL = (LAS int*)(wl + 17408); LAS float* LR = (LAS float*)(wl + 17920);
    const int b = bg >> 1, g = bg & 1, t0 = 8 * tile8;
    const int cur = t0 >> 6, nrest = cur >= 16 ? 13 : (cur > 2 ? cur - 2 : 0);
    const size_t tok0 = (size_t)b * S + t0;
    const int n = lane & 31, h = lane >> 5, ql = n >> 2, r = n & 3, lofs = lane * 8;
    const int tq = t0 + ql; const size_t tok = tok0 + ql;
    const bool has_cmp = t0 + 7 >= 31;
    const int cthi = has_cmp ? ((t0 + 7 - 31) >> 4) >> 5 : 0; const int clim = (tq >= 31) ? ((tq - 31) >> 4) : -1;
    float inv_c = 0.f;
    {
        bf16x8 q[8];
        const bf16_t* qp = QR + tok * 1024 + (4 * g + r) * 128 + 8 * h;
#pragma unroll
        for (int ks = 0; ks < 8; ++ks) q[ks] = *(const bf16x8*)(qp + 16 * ks);
        f32x16 Oc[4];
#pragma unroll
        for (int dt = 0; dt < 4; ++dt)
#pragma unroll
            for (int i = 0; i < 16; ++i) Oc[dt][i] = 0.f;
        if (has_cmp) {
            const float l = attn_pass1(KC, 0, cthi, q, -1, clim, lofs, h);
            inv_c = l > 0.f ? 1.f / l : 0.f;
            const float g0 = sigmoidf_(GL[tok * 24 + (4 * g + r) * 3 + 0]);
            if (cur >= 16) (void)attn_pass2<true, true, true>(KC, VCT, 0, cthi, q, -1, clim, inv_c, g0, Oc, IMPL, CARL, n, h, lofs);
            else (void)attn_pass2<false, true, true>(KC, VCT, 0, cthi, q, -1, clim, inv_c, g0, Oc, nullptr, nullptr, n, h, lofs);
        }
        LDS_WAIT();
        if (cur >= 16) {
#pragma unroll 1
            for (int qi = 0; qi < 8; ++qi) {
                LAS int* sel = SEL + qi * 16;
                int vb[4];
#pragma unroll
                for (int i = 0; i < 4; ++i) { const int j = lane + 64 * i; vb[i] = (j >= 1 && j <= cur - 2) ? __float_as_int(fmaxf(IMPL[qi * 256 + j] + CARL[qi * 256 + j], 0.f)) : -1; }
                int Tb = 0;
#pragma unroll 1
                for (int bit = 30; bit >= 0; --bit) {
                    const int cand = Tb | (1 << bit); int c = 0;
#pragma unroll
                    for (int i = 0; i < 4; ++i) c += __builtin_popcountll(__ballot(vb[i] >= cand));
                    if (c >= 13) Tb = cand;
                }
                int base = 0;
#pragma unroll
                for (int i = 0; i < 4; ++i) { const unsigned long long m = __ballot(vb[i] > Tb);
                    const int pre = __builtin_amdgcn_mbcnt_hi((unsigned)(m >> 32), __builtin_amdgcn_mbcnt_lo((unsigned)m, 0u));
                    if (vb[i] > Tb) sel[base + pre] = lane + 64 * i;
                    base += __builtin_popcountll(m); }
                const int need = 13 - base; int taken = 0;
#pragma unroll
                for (int i = 0; i < 4; ++i) { const unsigned long long m = __ballot(vb[i] == Tb);
                    const int pre = __builtin_amdgcn_mbcnt_hi((unsigned)(m >> 32), __builtin_amdgcn_mbcnt_lo((unsigned)m, 0u));
                    if (vb[i] == Tb && taken + pre < need) sel[base + taken + pre] = lane + 64 * i;
                    taken += __builtin_popcountll(m); }
            }
        } else if (lane < 13) {
#pragma unroll
            for (int qi = 0; qi < 8; ++qi) SEL[qi * 16 + lane] = lane + 1;
        }
        LDS_WAIT();
#pragma unroll
        for (int dt = 0; dt < 4; ++dt)
#pragma unroll
            for (int i4 = 0; i4 < 4; ++i4) { u32x2 w; w.x = pk2(Oc[dt][4 * i4], Oc[dt][4 * i4 + 1]); w.y = pk2(Oc[dt][4 * i4 + 2], Oc[dt][4 * i4 + 3]);
                *(LAS u32x2*)(OCB + n * 136 + 32 * dt + 8 * i4 + 4 * h) = w; }
        LDS_WAIT();
    }
    if (nrest > 0) {
        const int lb = opaque(lane);
        const int n16 = lb & 15, kq = lb >> 4, r16 = n16 & 3, lo16 = lb * 16;
        const int total = 8 * nrest;
        const unsigned char* qbase = (const unsigned char*)(ws + WS_QR8) + tok0 * 1024 + (4 * g + r16) * 128 + 8 * kq;
        u32x4 kA[8], vA[8]; u32x2 q16[4];
        int jcur = __builtin_amdgcn_readfirstlane(SEL[0]);
        {
            const unsigned char* Kp = KSLb + (size_t)jcur * 8192 + lo16; const unsigned char* Vp = VSLb + (size_t)jcur * 8192 + lo16;
#pragma unroll
            for (int i = 0; i < 8; ++i) kA[i] = *(const u32x4*)(Kp + i * 1024);
#pragma unroll
            for (int i = 0; i < 8; ++i) vA[i] = *(const u32x4*)(Vp + i * 1024);
#pragma unroll
            for (int ks = 0; ks < 4; ++ks) q16[ks] = *(const u32x2*)(qbase + 32 * ks);
        }
        f32x4 Os[8]; float l = 0.f;
#pragma unroll
        for (int dt = 0; dt < 8; ++dt) Os[dt] = (f32x4){0.f, 0.f, 0.f, 0.f};
        int qi = 0, si = 0;
#pragma unroll 1
        for (int f = 0; f < total; ++f) {
            int sn = si + 1, qn = qi; if (sn == nrest) { sn = 0; qn = qi + 1; }
            const bool hasn = f + 1 < total, lastb = (si == nrest - 1);
            const int jn = hasn ? __builtin_amdgcn_readfirstlane(SEL[qn * 16 + sn]) : jcur;
            f32x4 s[4];
            __builtin_amdgcn_s_setprio(1);
#pragma unroll
            for (int kt = 0; kt < 4; ++kt) { s[kt] = (f32x4){0.f, 0.f, 0.f, 0.f};
#pragma unroll
                for (int kp = 0; kp < 2; ++kp) { const u32x4 rw = kA[kt * 2 + kp];
                    s[kt] = MFMA16F8(mk64(rw.x, rw.y), mk64(q16[2 * kp].x, q16[2 * kp].y), s[kt]); s[kt] = MFMA16F8(mk64(rw.z, rw.w), mk64(q16[2 * kp + 1].x, q16[2 * kp + 1].y), s[kt]); } }
            __builtin_amdgcn_s_setprio(0);
            { const unsigned char* Kp = KSLb + (size_t)jn * 8192 + lo16;
#pragma unroll
                for (int i = 0; i < 8; ++i) kA[i] = *(const u32x4*)(Kp + i * 1024); }
            if (lastb && hasn) {
#pragma unroll
                for (int ks = 0; ks < 4; ++ks) q16[ks] = *(const u32x2*)(qbase + (size_t)qn * 1024 + 32 * ks);
            }
#pragma unroll
            for (int kt = 0; kt < 4; ++kt)
#pragma unroll
                for (int e = 0; e < 4; ++e) { const float ev = __builtin_amdgcn_exp2f(s[kt][e]); s[kt][e] = ev; l += ev; }
#pragma unroll
            for (int u = 0; u < 2; ++u) {
                u32x4 pw; pw.x = pk2(s[2 * u][0], s[2 * u][1]); pw.y = pk2(s[2 * u][2], s[2 * u][3]); pw.z = pk2(s[2 * u + 1][0], s[2 * u + 1][1]); pw.w = pk2(s[2 * u + 1][2], s[2 * u + 1][3]);
                const bf16x8 pb = __builtin_bit_cast(bf16x8, pw);
                __builtin_amdgcn_s_setprio(1);
#pragma unroll
                for (int dp = 0; dp < 4; ++dp) { const u32x4 rw = vA[u * 4 + dp];
                    Os[2 * dp] = MFMA16(fp8_frag(rw.x, rw.y), pb, Os[2 * dp]); Os[2 * dp + 1] = MFMA16(fp8_frag(rw.z, rw.w), pb, Os[2 * dp + 1]); }
                __builtin_amdgcn_s_setprio(0);
            }
            { const unsigned char* Vp = VSLb + (size_t)jn * 8192 + lo16;
#pragma unroll
                for (int i = 0; i < 8; ++i) vA[i] = *(const u32x4*)(Vp + i * 1024); }
            if (lastb) {
                l += __shfl_xor(l, 16); l += __shfl_xor(l, 32);
                if (n16 < 4) { LAS bf16_t* op = OSB + (qi * 4 + r16) * 136 + 4 * kq;
#pragma unroll
                    for (int dt = 0; dt < 8; ++dt) { u32x2 w; w.x = pk2(Os[dt].x, Os[dt].y); w.y = pk2(Os[dt].z, Os[dt].w); *(LAS u32x2*)(op + 16 * dt) = w; }
                    if (kq == 0) LR[qi * 4 + r16] = l; }
#pragma unroll
                for (int dt = 0; dt < 8; ++dt) Os[dt] = (f32x4){0.f, 0.f, 0.f, 0.f};
                l = 0.f;
            }
            si = sn; qi = qn; jcur = jn;
        }
    } else {
        const unsigned zz = (unsigned)opaque(0);
#pragma unroll
        for (int i = 0; i < 9; ++i) { const int idx = lane + 64 * i; if (idx < 32 * 136 / 8) *(LAS u32x4*)(OSB + 8 * idx) = (u32x4){zz, zz, zz, zz}; }
        if (lane < 32) LR[lane] = 0.f;
    }
    LDS_WAIT();
    {
        bf16x8 q[8];
        const bf16_t* qp = QR + tok * 1024 + (4 * g + r) * 128 + 8 * h;
#pragma unroll
        for (int ks = 0; ks < 8; ++ks) q[ks] = *(const bf16x8*)(qp + 16 * ks);
        const float* glp = GL + tok * 24 + (4 * g + r) * 3;
        const float g1 = sigmoidf_(glp[1]), g2 = sigmoidf_(glp[2]);
        f32x16 O[4];
#pragma unroll
        for (int dt = 0; dt < 4; ++dt)
#pragma unroll
            for (int i = 0; i < 16; ++i) O[dt][i] = 0.f;
        {
            const int lo_key = t0 - 511 > 0 ? t0 - 511 : 0; const int tlo = lo_key >> 5, thi = (t0 + 7) >> 5;
            float l = attn_pass2<false, true>(KW, VWT, tlo, thi, q, tq - 512, tq, 1.f, 1.f, O, nullptr, nullptr, n, h, lofs);
            l += __shfl_xor(l, 32);
            const float sc = g2 / l;
#pragma unroll
            for (int dt = 0; dt < 4; ++dt)
#pragma unroll
                for (int i = 0; i < 16; ++i) O[dt][i] *= sc;
        }
        {
            const int f_hi = cur >= 2 ? 5 : 2 * cur + 1, f_at = cur >= 2 ? 2 : 0x7fffffff, f_gap = 2 * cur - 4;
            const float lf = attn_pass1(KS32, 0, f_hi, q, -1, tq, lofs, h, f_at, f_gap);
            const float lt = lf + LR[n];
            const float sc = g1 / lt;
            (void)attn_pass2<false, true>(KS32, VS32, 0, f_hi, q, -1, tq, 1.f, sc, O, nullptr, nullptr, n, h, lofs, f_at, f_gap);
            float ss = 0.f;
#pragma unroll
            for (int dt = 0; dt < 4; ++dt)
#pragma unroll
                for (int i4 = 0; i4 < 4; ++i4) { const int eo = n * 136 + 32 * dt + 8 * i4 + 4 * h;
                    const u32x2 pc = *(const LAS u32x2*)(OCB + eo), pb2 = *(const LAS u32x2*)(OSB + eo);
                    const float cv[4] = {__uint_as_float(pc.x << 16), __uint_as_float(pc.x & 0xffff0000u), __uint_as_float(pc.y << 16), __uint_as_float(pc.y & 0xffff0000u)};
                    const float bv[4] = {__uint_as_float(pb2.x << 16), __uint_as_float(pb2.x & 0xffff0000u), __uint_as_float(pb2.y << 16), __uint_as_float(pb2.y & 0xffff0000u)};
#pragma unroll
                    for (int e = 0; e < 4; ++e) { const float v = O[dt][4 * i4 + e] + cv[e] + bv[e] * sc; O[dt][4 * i4 + e] = v; ss += v * v; } }
            ss += __shfl_xor(ss, 32);
            const float rstd = rsqrtf(ss * (1.f / 128.f) + EPS);
            LDS_WAIT();
#pragma unroll
            for (int dt = 0; dt < 4; ++dt)
#pragma unroll
                for (int i4 = 0; i4 < 4; ++i4) { u32x2 w; w.x = pk2(O[dt][4 * i4] * rstd, O[dt][4 * i4 + 1] * rstd); w.y = pk2(O[dt][4 * i4 + 2] * rstd, O[dt][4 * i4 + 3] * rstd);
                    *(LAS u32x2*)(OCB + n * 136 + 32 * dt + 8 * i4 + 4 * h) = w; }
        }
        LDS_WAIT();
#pragma unroll 2
        for (int q8 = 0; q8 < 8; ++q8) { const int e = lane * 8, rr = e >> 7, d = e & 127;
            const u32x4 w = *(const LAS u32x4*)(OCB + (q8 * 4 + rr) * 136 + d);
            *(u32x4*)(Y + (tok0 + q8) * D + 1024 + 4 * g * 128 + e) = w; }
    }
    LDS_WAIT();
}

__global__ void __launch_bounds__(512, 2) hymba_fwd(Args a) {
    extern __shared__ __attribute__((aligned(16))) unsigned char lds_raw[];
    LAS unsigned char* lds = (LAS unsigned char*)lds_raw;
    cg::grid_group grid = cg::this_grid();
    const int tid0 = threadIdx.x, wave = __builtin_amdgcn_readfirstlane(tid0 >> 6), G = gridDim.x;
    const int gw = blockIdx.x * 8 + wave, NGW = G * 8;
    unsigned char* ws = a.ws;
    float* ADA = (float*)(ws + WS_ADA);
    bf16_t* XN = (bf16_t*)(ws + WS_XN);
    volatile LAS unsigned* bst = (volatile LAS unsigned*)(lds + 8 * WAVE_LDS);
    if (tid0 < 16) bst[tid0] = 0u;
    __syncthreads();
    if (blockIdx.x == 0) { unsigned* cw = (unsigned*)(ws + WS_BAR); for (int i = tid0; i < 4096; i += 512) __hip_atomic_store(cw + i, 0u, __ATOMIC_RELAXED, __HIP_MEMORY_SCOPE_AGENT); }
    grid.sync();
    const XcdBarrier xbar = xcd_barrier_post((unsigned*)(ws + WS_BAR), bst);

    { const int tid = opaque(tid0); p0_prologue(a, lds, tid, tid & 63, wave, G); }
    xcd_barrier(xbar);
    { const int lane = opaque(tid0) & 63;
      norm_mod_rows(a.in[I_X], a.in[I_NMIX], ADA, 0, 1, XN, gw, NGW, lane);
      bias13_rows((const bf16_t*)(ws + WS_W13), ADA, (float*)(ws + WS_BIAS13), gw, NGW, lane);
      float* sq = (float*)(ws + WS_SUMSQ); for (int i = blockIdx.x * 512 + opaque(tid0); i < T; i += G * 512) sq[i] = 0.f; }
    xcd_barrier(xbar);
    {
        pg8::Gemm g{XN, (const bf16_t*)(ws + WS_WIN), T, INWP, D, D}; pg8::StaticOrder so; so.init(T, INWP, G, (int)blockIdx.x, 4);
        pg8::EpiProj E{(bf16_t*)(ws + WS_CONVIN), (bf16_t*)(ws + WS_KV6), (float*)(ws + WS_GL)};
        pg8::gemm_phase<pg8::EpiProj, pg8::StaticOrder, true>(lds, g, so, E);
    }
    xcd_barrier(xbar);
    {
        const int NGEMM = (G >= 64) ? 32 : 0;
        if ((int)blockIdx.x < NGEMM) {
            const int kv = blockIdx.x >> 4;
            pg8::Gemm g{(const bf16_t*)(ws + WS_KV6) + (size_t)kv * 4 * S * 128, (const bf16_t*)(ws + (kv ? WS_CW1V : WS_CW1K)), 4096, 256, 4096, 2048};
            pg8::OneUnit ou{(int)(blockIdx.x & 15)};
            pg8::EpiHid E{(float*)(ws + WS_HID) + (size_t)kv * 4096 * 256, (const float*)(ws + WS_CB1) + kv * 256};
            pg8::gemm_phase<pg8::EpiHid, pg8::OneUnit, false>(lds, g, ou, E);
        } else {
            const int ew = (blockIdx.x - NGEMM) * 8 + wave, NEW = (G - NGEMM) * 8, lane = opaque(tid0) & 63;
            LAS unsigned char* wl = lds + wave * WAVE_LDS;
            conv_range(a, (const bf16_t*)(ws + WS_CONVIN), (bf16_t*)(ws + WS_Y), (int)((long)ew * T / NEW), (int)((long)(ew + 1) * T / NEW), lane);
            for (int it = ew; it < T; it += NEW) normrope_item(a, ws, it, lane);
            for (int it = ew; it < 3072; it += NEW) vtrans_item(ws, it >> 10, it & 1023, wl, lane);
        }
        if (NGEMM == 0) {
            for (int u = blockIdx.x; u < 32; u += G) { const int kv = u >> 4;
                pg8::Gemm g{(const bf16_t*)(ws + WS_KV6) + (size_t)kv * 4 * S * 128, (const bf16_t*)(ws + (kv ? WS_CW1V : WS_CW1K)), 4096, 256, 4096, 2048};
                pg8::OneUnit ou{u & 15}; pg8::EpiHid E{(float*)(ws + WS_HID) + (size_t)kv * 4096 * 256, (const float*)(ws + WS_CB1) + kv * 256};
                __syncthreads();
                pg8::gemm_phase<pg8::EpiHid, pg8::OneUnit, false>(lds, g, ou, E); }
        }
    }
    xcd_barrier(xbar);
    cmp2_phase(a, ws, lds, opaque(tid0), wave, G);
    xcd_barrier(xbar);
    {
        LAS unsigned char* wl = lds + wave * WAVE_LDS;
        unsigned* heads = (unsigned*)(ws + WS_BAR) + 3584;
        const int bg0 = (int)(blockIdx.x & 3);
#pragma unroll 1
        for (int sidx = 0; sidx < 4; ++sidx) {
            const int bg = (bg0 + sidx) & 3;
#pragma unroll 1
            for (;;) {
                int it = 0; if ((tid0 & 63) == 0) it = (int)atomicAdd(heads + 64 * bg, 1u); it = __builtin_amdgcn_readfirstlane(it);
                if (it >= 2048) break;
                attn_item(a, ws, wl, bg, 2047 - it, opaque(tid0) & 63);
            }
        }
    }
    xcd_barrier(xbar);
    {
        pg8::Gemm g{(const bf16_t*)(ws + WS_Y), (const bf16_t*)(ws + WS_WOUT), T, D, D, D}; pg8::StaticOrder so; so.init(T, D, G, (int)blockIdx.x, 4);
        pg8::EpiRes2 E{a.in[I_X], (bf16_t*)(ws + WS_X1B), ADA + 2 * 2048, a.in[I_NFFN], ADA + 4 * 2048, XN, (float*)(ws + WS_SUMSQ)};
        pg8::gemm_phase<pg8::EpiRes2, pg8::StaticOrder, true>(lds, g, so, E);
    }
    xcd_barrier(xbar);
    {
        pg8::Gemm g{XN, (const bf16_t*)(ws + WS_W13), T, 2 * DFF, D, D}; pg8::StaticOrder so; so.init(T, 2 * DFF, G, (int)blockIdx.x, 4);
        pg8::EpiSwiGLU E{(bf16_t*)(ws + WS_ACT), (const float*)(ws + WS_SUMSQ), (const float*)(ws + WS_BIAS13)};
        pg8::gemm_phase<pg8::EpiSwiGLU, pg8::StaticOrder, true>(lds, g, so, E);
    }
    xcd_barrier(xbar);
    {
        pg8::Gemm g{(const bf16_t*)(ws + WS_ACT), (const bf16_t*)(ws + WS_W2), T, D, DFF, DFF}; pg8::StaticOrder so; so.init(T, D, G, (int)blockIdx.x, 2);
        pg8::EpiRes E{(const bf16_t*)(ws + WS_X1B), a.out, ADA + 5 * 2048};
        pg8::gemm_phase<pg8::EpiRes, pg8::StaticOrder, true>(lds, g, so, E);
    }
}

extern "C" void kernel_launch(void* const* d_in, const int* in_sizes, int n_in, void* d_out, int out_size, void* d_ws, size_t ws_size, hipStream_t stream) {
    static int grid = 0;
    if (grid == 0) {
        if (n_in != 25 || out_size != T * D || ws_size < WS_END) { fprintf(stderr, "kernel_launch: unexpected shapes (n_in %d, out %d, ws %zu)\n", n_in, out_size, ws_size); grid = -1; return; }
        int dev = 0, cus = 0, per_cu = 0;
        hipGetDevice(&dev); hipDeviceGetAttribute(&cus, hipDeviceAttributeMultiprocessorCount, dev);
        hipFuncSetAttribute((const void*)hymba_fwd, hipFuncAttributeMaxDynamicSharedMemorySize, LDS_BYTES);
        if (hipOccupancyMaxActiveBlocksPerMultiprocessor(&per_cu, (const void*)hymba_fwd, 512, LDS_BYTES) != hipSuccess || per_cu < 1) per_cu = 1;
        (void)hipGetLastError();
        if (per_cu > 1) per_cu = 1;
        grid = cus * per_cu;
    }
    if (grid < 0) return;
    Args a{};
    for (int i = 0; i < 25; ++i) a.in[i] = (const float*)d_in[i];
    a.out = (float*)d_out; a.ws = (unsigned char*)d_ws;
    void* args[] = {&a};
    hipError_t e = hipLaunchCooperativeKernel((const void*)hymba_fwd, dim3(grid), dim3(512), args, LDS_BYTES, stream);
    if (e != hipSuccess) fprintf(stderr, "cooperative launch failed: %s (grid %d)\n", hipGetErrorString(e), grid);
}
```
